# Optimizing an MI355X kernel written in HIP

```python
import math
import jax, jax.numpy as jnp
from jax import lax
import numpy as np

D_MODEL = 1024
BATCH = 16
SEQ = 4096
DEPTH = 2

N_EVEN = (DEPTH + 1) // 2
N_ODD = DEPTH // 2

SSM_WIDTH = D_MODEL // 4
SSM_GROUP = 16
SSM_GROUPS = SSM_WIDTH // SSM_GROUP
SSM_STATE = 64
GMLP_WIDTH = D_MODEL - SSM_WIDTH
GMLP_HEAD = 128
GMLP_HEADS = GMLP_WIDTH // GMLP_HEAD
CHUNK = 128
EVEN_IN = SSM_WIDTH + 2 * GMLP_WIDTH

CONV_WIDTH = 3
D_FF = 2816
EPS = 1e-6
DT_MIN = 1e-3
DT_MAX = 1e-1
LAMBDA_RE_MAX = -1e-4
RESID_SCALE = (2 * DEPTH) ** -0.5

kernel_name = "hybrid_s5_gmlp_shortconv_convffn"


def rmsnorm(x, g):
    xf = x.astype(jnp.float32)
    y = xf * lax.rsqrt(jnp.mean(xf * xf, axis=-1, keepdims=True) + EPS)
    return (y * g.astype(jnp.float32)).astype(x.dtype)


def causal_dwconv(x, w, b):
    k_w = w.shape[0]
    s = x.shape[1]
    xp = jnp.pad(x, ((0, 0), (k_w - 1, 0), (0, 0)))
    return b + sum(w[k] * xp[:, k:k + s] for k in range(k_w))


def s5_mixer(u, lam_re, lam_im, log_dt, b_re, b_im, c_re, c_im, d_skip, w_glu, b_glu):
    bsz, s, _ = u.shape
    uf = u.astype(jnp.float32).reshape(bsz, s, SSM_GROUPS, SSM_GROUP)
    lr = jnp.minimum(lam_re.astype(jnp.float32), LAMBDA_RE_MAX)
    li = lam_im.astype(jnp.float32)
    dt = jnp.exp(log_dt.astype(jnp.float32))[:, None]
    mag = jnp.exp(lr * dt)
    ab_re = mag * jnp.cos(li * dt)
    ab_im = mag * jnp.sin(li * dt)
    den = lr * lr + li * li
    nr = ab_re - 1.0
    ni = ab_im
    z_re = ((nr * lr + ni * li) / den)[..., None]
    z_im = ((ni * lr - nr * li) / den)[..., None]
    br = b_re.astype(jnp.float32)
    bi = b_im.astype(jnp.float32)
    bb_re = z_re * br - z_im * bi
    bb_im = z_re * bi + z_im * br
    x_re = jnp.einsum('bsgh,gph->bsgp', uf, bb_re)
    x_im = jnp.einsum('bsgh,gph->bsgp', uf, bb_im)
    a_re = jnp.broadcast_to(ab_re, (1, s) + ab_re.shape)
    a_im = jnp.broadcast_to(ab_im, (1, s) + ab_im.shape)

    def combine(left, right):
        a1r, a1i, b1r, b1i = left
        a2r, a2i, b2r, b2i = right
        return (a2r * a1r - a2i * a1i,
                a2r * a1i + a2i * a1r,
                a2r * b1r - a2i * b1i + b2r,
                a2r * b1i + a2i * b1r + b2i)

    _, _, h_re, h_im = lax.associative_scan(combine, (a_re, a_im, x_re, x_im), axis=1)
    y = (jnp.einsum('bsgp,ghp->bsgh', h_re, c_re.astype(jnp.float32))
         - jnp.einsum('bsgp,ghp->bsgh', h_im, c_im.astype(jnp.float32)))
    y = (y + d_skip.astype(jnp.float32).reshape(SSM_GROUPS, SSM_GROUP) * uf).reshape(bsz, s, SSM_WIDTH)
    y = jax.nn.gelu(y)
    y = y * jax.nn.sigmoid(y @ w_glu.astype(jnp.float32) + b_glu.astype(jnp.float32))
    return y.astype(u.dtype)


def gmlp_mixer(uv, w_s, b_s, g_v):
    bsz, s, _ = uv.shape
    u, v = jnp.split(jax.nn.gelu(uv), 2, axis=-1)
    v = rmsnorm(v, g_v).reshape(bsz, s // CHUNK, CHUNK, GMLP_HEADS, GMLP_HEAD)
    mask = jnp.tril(jnp.ones((CHUNK, CHUNK), dtype=bool))
    w = jnp.where(mask, w_s, 0)
    gate = jnp.einsum('hts,bnshc->bnthc', w, v) + b_s.T[None, None, :, :, None]
    return u * gate.reshape(bsz, s, GMLP_WIDTH)


def shortconv_mixer(p, w_conv, b_conv):
    bg, cg, hx = jnp.split(p, 3, axis=-1)
    return bg * causal_dwconv(cg * hx, w_conv, b_conv)


def conv_ffn(x, w_up, w_conv, b_conv, w_down):
    h = causal_dwconv(x @ w_up, w_conv, b_conv)
    gate, val = jnp.split(h, 2, axis=-1)
    return (jax.nn.silu(gate) * val) @ w_down


def setup_inputs(seed: int = 0) -> dict:
    key = jax.random.key(seed)
    ks = iter(jax.random.split(key, 32))
    f32 = jnp.float32
    nrm = lambda shape, std: std * jax.random.normal(next(ks), shape, f32)
    d = D_MODEL
    inp = {}
    inp["x"] = nrm((BATCH, SEQ, d), 1.0)
    inp["mix_norm_g"] = 1.0 + nrm((DEPTH, d), 0.02)
    inp["ffn_norm_g"] = 1.0 + nrm((DEPTH, d), 0.02)
    inp["final_norm_g"] = 1.0 + nrm((d,), 0.02)
    inp["ev_w_in"] = nrm((N_EVEN, d, EVEN_IN), d ** -0.5)
    inp["ev_w_out"] = nrm((N_EVEN, d, d), d ** -0.5 * RESID_SCALE)
    inp["s5_lam_re"] = -0.5 + nrm((N_EVEN, SSM_GROUPS, SSM_STATE), 0.01)
    n_idx = jnp.arange(SSM_STATE, dtype=f32)
    inp["s5_lam_im"] = math.pi * n_idx + nrm((N_EVEN, SSM_GROUPS, SSM_STATE), 0.01)
    inp["s5_log_dt"] = jax.random.uniform(next(ks), (N_EVEN, SSM_GROUPS), f32,
                                          math.log(DT_MIN), math.log(DT_MAX))
    inp["s5_b_re"] = nrm((N_EVEN, SSM_GROUPS, SSM_STATE, SSM_GROUP), (2 * SSM_GROUP) ** -0.5)
    inp["s5_b_im"] = nrm((N_EVEN, SSM_GROUPS, SSM_STATE, SSM_GROUP), (2 * SSM_GROUP) ** -0.5)
    inp["s5_c_re"] = nrm((N_EVEN, SSM_GROUPS, SSM_GROUP, SSM_STATE), SSM_STATE ** -0.5)
    inp["s5_c_im"] = nrm((N_EVEN, SSM_GROUPS, SSM_GROUP, SSM_STATE), SSM_STATE ** -0.5)
    inp["s5_d"] = nrm((N_EVEN, SSM_WIDTH), 1.0)
    inp["s5_w_glu"] = nrm((N_EVEN, SSM_WIDTH, SSM_WIDTH), SSM_WIDTH ** -0.5)
    inp["s5_b_glu"] = nrm((N_EVEN, SSM_WIDTH), 0.01)
    inp["gm_w_s"] = nrm((N_EVEN, GMLP_HEADS, CHUNK, CHUNK), CHUNK ** -0.5)
    inp["gm_b_s"] = 1.0 + nrm((N_EVEN, GMLP_HEADS, CHUNK), 0.01)
    inp["gm_v_g"] = 1.0 + nrm((N_EVEN, GMLP_WIDTH), 0.02)
    inp["od_w_in"] = nrm((N_ODD, d, 3 * d), d ** -0.5)
    inp["od_conv_w"] = nrm((N_ODD, CONV_WIDTH, d), CONV_WIDTH ** -0.5)
    inp["od_conv_b"] = nrm((N_ODD, d), 0.01)
    inp["od_w_out"] = nrm((N_ODD, d, d), d ** -0.5 * RESID_SCALE)
    inp["ffn_w_up"] = nrm((DEPTH, d, 2 * D_FF), d ** -0.5)
    inp["ffn_conv_w"] = nrm((DEPTH, CONV_WIDTH, 2 * D_FF), CONV_WIDTH ** -0.5)
    inp["ffn_conv_b"] = nrm((DEPTH, 2 * D_FF), 0.01)
    inp["ffn_w_down"] = nrm((DEPTH, D_FF, d), D_FF ** -0.5 * RESID_SCALE)
    return inp


def reference(x, mix_norm_g, ffn_norm_g, final_norm_g,
              ev_w_in, ev_w_out, s5_lam_re, s5_lam_im, s5_log_dt,
              s5_b_re, s5_b_im, s5_c_re, s5_c_im, s5_d, s5_w_glu, s5_b_glu,
              gm_w_s, gm_b_s, gm_v_g,
              od_w_in, od_conv_w, od_conv_b, od_w_out,
              ffn_w_up, ffn_conv_w, ffn_conv_b, ffn_w_down):
    h = x
    for layer in range(DEPTH):
        y = rmsnorm(h, mix_norm_g[layer])
        if layer % 2 == 0:
            e = layer // 2
            p = y @ ev_w_in[e]
            a_out = s5_mixer(p[..., :SSM_WIDTH], s5_lam_re[e], s5_lam_im[e], s5_log_dt[e],
                             s5_b_re[e], s5_b_im[e], s5_c_re[e], s5_c_im[e],
                             s5_d[e], s5_w_glu[e], s5_b_glu[e])
            b_out = gmlp_mixer(p[..., SSM_WIDTH:], gm_w_s[e], gm_b_s[e], gm_v_g[e])
            mix = jnp.concatenate([a_out, b_out], axis=-1) @ ev_w_out[e]
        else:
            o = layer // 2
            mix = shortconv_mixer(y @ od_w_in[o], od_conv_w[o], od_conv_b[o]) @ od_w_out[o]
        h = h + mix
        h = h + conv_ffn(rmsnorm(h, ffn_norm_g[layer]), ffn_w_up[layer], ffn_conv_w[layer],
                         ffn_conv_b[layer], ffn_w_down[layer])
    return rmsnorm(h, final_norm_g)
```

```cpp
#include <hip/hip_runtime.h>
#include <hip/hip_cooperative_groups.h>
#include <cstdio>
namespace cg = cooperative_groups;

#define LAS __attribute__((address_space(3)))
typedef unsigned short bf16_t;
typedef short bf16x8 __attribute__((ext_vector_type(8)));
typedef float f32x4 __attribute__((ext_vector_type(4)));
typedef unsigned u32x4 __attribute__((ext_vector_type(4)));
typedef unsigned u32x2 __attribute__((ext_vector_type(2)));

constexpr int MTOK = 65536;
constexpr float EPS = 1e-6f;
constexpr int BM = 256, BK = 64, HALF = 128, HTB = HALF * BK * 2, STAGE_BYTES = 8 * HTB, LDS_BYTES = STAGE_BYTES + 64, NXCD = 8, WGM = 8;

constexpr size_t O_WIN0 = 0;
constexpr size_t O_WOUT0 = O_WIN0 + (size_t)1792 * 1024 * 2;
constexpr size_t O_WUP = O_WOUT0 + (size_t)1024 * 1024 * 2;
constexpr size_t SZ_WUP = (size_t)5632 * 1024 * 2;
constexpr size_t O_WDN = O_WUP + 2 * SZ_WUP;
constexpr size_t SZ_WDN = (size_t)1024 * 2816 * 2;
constexpr size_t O_WODIN = O_WDN + 2 * SZ_WDN;
constexpr size_t O_WODOUT = O_WODIN + (size_t)3072 * 1024 * 2;
constexpr size_t O_WGLU = O_WODOUT + (size_t)1024 * 1024 * 2;
constexpr size_t O_M1T = O_WGLU + (size_t)256 * 256 * 2;
constexpr size_t O_T2T = O_M1T + (size_t)16 * 256 * 1024 * 2;
constexpr size_t O_WSB = O_T2T + (size_t)16 * 1024 * 1152 * 2;
constexpr size_t O_KTAB = O_WSB + (size_t)6 * 128 * 128 * 2;
constexpr size_t O_SS = O_KTAB + (size_t)16 * 64 * 256 * 4;
constexpr size_t O_BAR = O_SS + (size_t)6 * 65536 * 4;
constexpr size_t O_CWT = O_BAR + 16384;
constexpr size_t O_HB = O_CWT + (size_t)2 * 4 * 2816 * 4;
constexpr size_t O_R = O_HB + (size_t)MTOK * 1024 * 2;
constexpr size_t O_UH = O_R;
constexpr size_t O_S = O_UH + (size_t)16 * 2048 * 640 * 2;
constexpr size_t O_U = O_S + (size_t)32768 * 128 * 4;
constexpr size_t O_V = O_U + (size_t)MTOK * 768 * 2;
constexpr size_t O_Y1 = O_V + (size_t)MTOK * 768 * 2;
constexpr size_t O_MIX = O_Y1 + (size_t)MTOK * 256 * 2;
constexpr size_t O_END0 = O_MIX + (size_t)MTOK * 1024 * 2;
constexpr size_t O_BG = O_R;
constexpr size_t O_Z = O_BG + (size_t)MTOK * 1024 * 2;
static_assert(O_Z + (size_t)MTOK * 1024 * 2 <= O_MIX, "layer-1 mixer buffers overlap MIX");
constexpr size_t O_G = O_R;
constexpr size_t O_UB = O_G + (size_t)MTOK * 2816 * 2;
constexpr size_t O_END1 = O_UB + (size_t)1024 * 4 * 5632 * 2;
constexpr size_t WS_NEED = O_END0 > O_END1 ? O_END0 : O_END1;

struct Params {
    const float *x, *mix_g, *ffn_g, *fin_g, *ev_w_in, *ev_w_out, *lam_re, *lam_im, *log_dt, *b_re, *b_im, *c_re, *c_im, *s5_d, *w_glu, *b_glu,
        *gm_ws, *gm_bs, *gm_vg, *od_w_in, *od_cw, *od_cb, *od_w_out, *ffn_up, *ffn_cw, *ffn_cb, *ffn_dn;
    float* out; unsigned char* ws;
};

__device__ __forceinline__ unsigned cvt_pk_bf16(float lo, float hi) { unsigned r; asm("v_cvt_pk_bf16_f32 %0, %1, %2" : "=v"(r) : "v"(lo), "v"(hi)); return r; }
__device__ __forceinline__ u32x4 pack8(f32x4 a, f32x4 b) { u32x4 w; w.x = cvt_pk_bf16(a[0], a[1]); w.y = cvt_pk_bf16(a[2], a[3]); w.z = cvt_pk_bf16(b[0], b[1]); w.w = cvt_pk_bf16(b[2], b[3]); return w; }
__device__ __forceinline__ float bflo(unsigned w) { return __uint_as_float(w << 16); }
__device__ __forceinline__ float bfhi(unsigned w) { return __uint_as_float(w & 0xffff0000u); }
__device__ __forceinline__ void unpack8(u32x4 w, f32x4& a, f32x4& b) { a = (f32x4){bflo(w.x), bfhi(w.x), bflo(w.y), bfhi(w.y)}; b = (f32x4){bflo(w.z), bfhi(w.z), bflo(w.w), bfhi(w.w)}; }
__device__ __forceinline__ float gelu_t(float x) { const float u = x * (0.7978845608f + 0.0356774081f * x * x); return x * __builtin_amdgcn_rcpf(1.0f + __builtin_amdgcn_exp2f(-2.885390082f * u)); }
__device__ __forceinline__ float sigm(float x) { return __builtin_amdgcn_rcpf(1.0f + __builtin_amdgcn_exp2f(-1.442695041f * x)); }
__device__ __forceinline__ f32x4 gelu4(f32x4 v) { return (f32x4){gelu_t(v[0]), gelu_t(v[1]), gelu_t(v[2]), gelu_t(v[3])}; }
__device__ __forceinline__ float ror1(float v) { return __int_as_float(__builtin_amdgcn_update_dpp(0, __float_as_int(v), 0x121, 0xf, 0xf, false)); }
__device__ __forceinline__ float ror2(float v) { return __int_as_float(__builtin_amdgcn_update_dpp(0, __float_as_int(v), 0x122, 0xf, 0xf, false)); }
typedef _Float16 h2_t __attribute__((ext_vector_type(2)));
__device__ __forceinline__ unsigned pk_h2(float a, float b) { return __builtin_bit_cast(unsigned, __builtin_amdgcn_cvt_pkrtz(a, b)); }
__device__ __forceinline__ h2_t as_h2(unsigned v) { return __builtin_bit_cast(h2_t, v); }
__device__ __forceinline__ unsigned ror1u(unsigned v) { return (unsigned)__builtin_amdgcn_update_dpp(0, (int)v, 0x121, 0xf, 0xf, true); }
__device__ __forceinline__ unsigned ror2u(unsigned v) { return (unsigned)__builtin_amdgcn_update_dpp(0, (int)v, 0x122, 0xf, 0xf, true); }
__device__ __forceinline__ unsigned shr1_old(unsigned old, unsigned v) { return (unsigned)__builtin_amdgcn_update_dpp((int)old, (int)v, 0x111, 0xf, 0xf, false); }
__device__ __forceinline__ unsigned shr2_old(unsigned old, unsigned v) { return (unsigned)__builtin_amdgcn_update_dpp((int)old, (int)v, 0x112, 0xf, 0xf, false); }
__device__ __forceinline__ float rnorm(float ss) { return rsqrtf(ss * (1.0f / 1024.0f) + EPS); }
__device__ __forceinline__ float dot4(f32x4 a) { return (a[0] * a[0] + a[1] * a[1]) + (a[2] * a[2] + a[3] * a[3]); }

__host__ __device__ __forceinline__ int lds_byte(int r, int c) { const int st = (r >> 4) * 2 + (c >> 5), rr = r & 15, cc = c & 31, ob = rr * 64 + cc * 2; return st * 1024 + (ob ^ (((ob >> 9) & 1) << 5)); }
__host__ __device__ __forceinline__ void stage_rc(int b, int& R, int& C) { const int st = b / 1024, sb = b % 1024, swz = sb ^ (((sb >> 9) & 1) << 5); R = (st >> 1) * 16 + swz / 64; C = (st & 1) * 32 + (swz % 64) / 2; }
__host__ __device__ __forceinline__ int perm32(int rho) { const int n = rho >> 4, i = rho & 15; return 8 * (i >> 2) + 4 * n + (i & 3); }

struct Unit { int pm, pn; };
struct Gemm { const bf16_t* A; const bf16_t* Bt; int M, N, K, lda; int bgt; size_t bgs; };
struct StaticOrder {
    int nM, nN, nwg, G, c;
    __device__ void init(int M, int N, int G_, int c_) { nM = M / BM; nN = N / BM; nwg = nM * nN; G = G_; c = c_; }
    __device__ bool next(int i, Unit& u) const {
        const long L = (long)i * G + c; if (L >= nwg) return false;
        int wgid = (int)L; { const int q = nwg / NXCD, r = nwg % NXCD, xcd = wgid % NXCD, off = wgid / NXCD; wgid = (xcd < r ? xcd * (q + 1) : r * (q + 1) + (xcd - r) * q) + off; }
        const int nig = WGM * nN, gid = wgid / nig, fm = gid * WGM, gsz = (nM - fm) < WGM ? (nM - fm) : WGM;
        u.pm = fm + ((wgid % nig) % gsz); u.pn = (wgid % nig) / gsz; return true;
    }
};

template <class Epi>
__device__ __forceinline__ void gemm_phase(LAS unsigned char* lds, const Gemm g, const StaticOrder& S, const Epi& E) {
    int tid = threadIdx.x; asm volatile("" : "+v"(tid)); const int wid = __builtin_amdgcn_readfirstlane(tid >> 6), lane = tid & 63, wr = wid >> 2, wc = wid & 3, fr = lane & 15, fq = lane >> 4;
    const int K = g.K, nt = K / BK, lda = g.lda;
    unsigned voffA[2], voffB[2];
#pragma unroll
    for (int i = 0; i < 2; ++i) { int R, C; stage_rc(tid * 16 + i * 8192, R, C); const int Rb = (R & ~31) + perm32(R & 31);
        voffA[i] = (unsigned)(R * lda + C) * 2u; voffB[i] = (unsigned)(Rb * K + C) * 2u; }
    const size_t kstep = (size_t)(BK * 2);
    const size_t hstepA = (size_t)HALF * lda * 2, hstepB = (size_t)HALF * K * 2;
    const size_t tstepA = 2 * hstepA, tstepB = 2 * hstepB;
    const unsigned ldsw = (unsigned)wid * 1024u;
    const int aoff = lds_byte(wr * 64 + fr, fq * 8), boff = lds_byte(wc * 32 + fr, fq * 8);
#define PG8_SA(b, h) (((b) * 2 + (h)) * HTB)
#define PG8_SB(b, h) ((4 + (b) * 2 + (h)) * HTB)
#define PG8_STAGE(bufoff, gbase, voff) do { _Pragma("unroll") for (int _i = 0; _i < 2; ++_i) \
        __builtin_amdgcn_global_load_lds((const unsigned*)((const char*)(gbase) + (voff)[_i]), (LAS unsigned*)(lds + (bufoff) + ldsw + _i * 8192), 16, 0, 0); } while (0)
#define PG8_LDA(dst, b, h) do { _Pragma("unroll") for (int m = 0; m < 4; ++m) _Pragma("unroll") for (int k = 0; k < 2; ++k) dst[m][k] = *(const LAS bf16x8*)(lds + PG8_SA(b, h) + aoff + m * 2048 + k * 1024); } while (0)
#define PG8_LDB(dst, b, h) do { _Pragma("unroll") for (int n = 0; n < 2; ++n) _Pragma("unroll") for (int k = 0; k < 2; ++k) dst[n][k] = *(const LAS bf16x8*)(lds + PG8_SB(b, h) + boff + n * 2048 + k * 1024); } while (0)
#define PG8_MMA(ai, bj, At, Bt) do { __builtin_amdgcn_s_setprio(1); _Pragma("unroll") for (int m = 0; m < 4; ++m) _Pragma("unroll") for (int n = 0; n < 2; ++n) _Pragma("unroll") for (int k = 0; k < 2; ++k) \
        acc[ai][bj][m][n] = __builtin_amdgcn_mfma_f32_16x16x32_bf16(Bt[n][k], At[m][k], acc[ai][bj][m][n], 0, 0, 0); __builtin_amdgcn_s_setprio(0); } while (0)
#define PG8_WAIT_V(n) asm volatile("s_waitcnt vmcnt(" #n ")" ::: "memory")
#define PG8_WAIT_L(n) asm volatile("s_waitcnt lgkmcnt(" #n ")" ::: "memory")
#define PG8_BAR __builtin_amdgcn_s_barrier()
#define PG8_SCHED __builtin_amdgcn_sched_barrier(0)
    Unit cur, nxt; int ui = 0;
    if (!S.next(0, cur)) return;
    f32x4 acc[2][2][4][2];
#pragma unroll
    for (int a = 0; a < 2; ++a)
#pragma unroll
        for (int b = 0; b < 2; ++b)
#pragma unroll
            for (int m = 0; m < 4; ++m)
#pragma unroll
                for (int n = 0; n < 2; ++n) acc[a][b][m][n] = (f32x4){0.f, 0.f, 0.f, 0.f};
    bf16x8 At[4][2], B0[2][2], B1[2][2];
    const char* cA = (const char*)g.A + (size_t)cur.pm * tstepA;
    const char* cB = (const char*)g.Bt + (size_t)cur.pn * tstepB + (g.bgt ? (size_t)(cur.pm / g.bgt) * g.bgs : (size_t)0);
    PG8_STAGE(PG8_SB(0, 0), cB, voffB); PG8_STAGE(PG8_SA(0, 0), cA, voffA); PG8_STAGE(PG8_SB(0, 1), cB + hstepB, voffB); PG8_STAGE(PG8_SA(0, 1), cA + hstepA, voffA);
    if (wr == 1) PG8_BAR;
    PG8_WAIT_V(4); PG8_BAR;
    PG8_STAGE(PG8_SB(1, 0), cB + kstep, voffB); PG8_STAGE(PG8_SA(1, 0), cA + kstep, voffA); PG8_STAGE(PG8_SB(1, 1), cB + hstepB + kstep, voffB);
    PG8_WAIT_V(6); PG8_BAR;
    for (;;) {
        const bool has_next = S.next(ui + 1, nxt);
        const char* nA = has_next ? (const char*)g.A + (size_t)nxt.pm * tstepA : cA;
        const char* nB = has_next ? (const char*)g.Bt + (size_t)nxt.pn * tstepB + (g.bgt ? (size_t)(nxt.pm / g.bgt) * g.bgs : (size_t)0) : cB;
        for (int t = 0; t < nt; t += 2) {
            const bool last = (t == nt - 2);
            const char* a1 = cA + (size_t)(t + 1) * kstep;
            const char* a2 = last ? nA : cA + (size_t)(t + 2) * kstep; const char* b2 = last ? nB : cB + (size_t)(t + 2) * kstep;
            const char* a3 = a2 + kstep; const char* b3 = b2 + kstep;
            PG8_LDB(B0, 0, 0); PG8_SCHED; PG8_LDA(At, 0, 0); PG8_STAGE(PG8_SA(1, 1), a1 + hstepA, voffA);
            PG8_WAIT_L(8); PG8_BAR; PG8_WAIT_L(0); PG8_MMA(0, 0, At, B0); PG8_BAR; PG8_SCHED;
            PG8_LDB(B1, 0, 1); PG8_STAGE(PG8_SB(0, 0), b2, voffB);
            PG8_BAR; PG8_WAIT_L(0); PG8_MMA(0, 1, At, B1); PG8_BAR;
            PG8_LDA(At, 0, 1); PG8_STAGE(PG8_SA(0, 0), a2, voffA);
            PG8_BAR; PG8_WAIT_L(0); PG8_MMA(1, 0, At, B0); PG8_BAR; PG8_SCHED;
            PG8_STAGE(PG8_SB(0, 1), b2 + hstepB, voffB);
            PG8_WAIT_V(6); PG8_BAR; PG8_MMA(1, 1, At, B1); PG8_BAR;
            PG8_LDB(B0, 1, 0); PG8_SCHED; PG8_LDA(At, 1, 0); PG8_STAGE(PG8_SA(0, 1), a2 + hstepA, voffA);
            PG8_WAIT_L(8); PG8_BAR; PG8_WAIT_L(0); PG8_MMA(0, 0, At, B0); PG8_BAR; PG8_SCHED;
            PG8_LDB(B1, 1, 1); PG8_STAGE(PG8_SB(1, 0), b3, voffB);
            PG8_BAR; PG8_WAIT_L(0); PG8_MMA(0, 1, At, B1); PG8_BAR;
            PG8_LDA(At, 1, 1); PG8_STAGE(PG8_SA(1, 0), a3, voffA);
            PG8_BAR; PG8_WAIT_L(0); PG8_MMA(1, 0, At, B0); PG8_BAR; PG8_SCHED;
            PG8_STAGE(PG8_SB(1, 1), b3 + hstepB, voffB);
            PG8_WAIT_V(6); PG8_BAR; PG8_MMA(1, 1, At, B1); PG8_BAR;
        }
        { int t2 = threadIdx.x; asm volatile("" : "+v"(t2)); E(acc, cur, wr, wc, t2 & 15, (t2 & 63) >> 4); }
        if (!has_next) break;
#pragma unroll
        for (int a = 0; a < 2; ++a)
#pragma unroll
            for (int b = 0; b < 2; ++b)
#pragma unroll
                for (int m = 0; m < 4; ++m)
#pragma unroll
                    for (int n = 0; n < 2; ++n) acc[a][b][m][n] = (f32x4){0.f, 0.f, 0.f, 0.f};
        cur = nxt; cA = nA; cB = nB; ++ui;
    }
    PG8_WAIT_V(0);
    if (wr == 0) PG8_BAR;
    PG8_BAR;
#undef PG8_SA
#undef PG8_SB
#undef PG8_STAGE
#undef PG8_LDA
#undef PG8_LDB
#undef PG8_MMA
#undef PG8_WAIT_V
#undef PG8_WAIT_L
#undef PG8_BAR
#undef PG8_SCHED
}

typedef f32x4 Acc[2][2][4][2];

struct EpiIn0 {
    const float* ss; bf16_t* UH; bf16_t* U; bf16_t* V; float* vss;
    __device__ __forceinline__ void operator()(Acc& acc, const Unit& u, int wr, int wc, int fr, int fq) const {
        const int row0 = u.pm * BM + wr * 64 + fr, cin = wc * 32 + 8 * fq;
        float rsv[2][4];
#pragma unroll
        for (int ai = 0; ai < 2; ++ai)
#pragma unroll
            for (int m = 0; m < 4; ++m) rsv[ai][m] = ss[row0 + ai * HALF + m * 16];
        __builtin_amdgcn_sched_barrier(0);
#pragma unroll
        for (int ai = 0; ai < 2; ++ai)
#pragma unroll
            for (int m = 0; m < 4; ++m) {
                const int row = row0 + ai * HALF + m * 16; const float rs = rnorm(rsv[ai][m]);
                if (u.pn == 0) {
#pragma unroll
                    for (int bj = 0; bj < 2; ++bj) { const int col = bj * HALF + cin, g = col >> 4, ch0 = col & 15;
                        *(u32x4*)(UH + ((size_t)(g * 2048 + (row >> 5)) * 640 + (row & 31) * 16 + ch0)) = pack8(acc[ai][bj][m][0] * rs, acc[ai][bj][m][1] * rs); }
                } else if (u.pn < 4) {
#pragma unroll
                    for (int bj = 0; bj < 2; ++bj) { const int col = (u.pn - 1) * BM + bj * HALF + cin;
                        *(u32x4*)(U + (size_t)row * 768 + col) = pack8(gelu4(acc[ai][bj][m][0] * rs), gelu4(acc[ai][bj][m][1] * rs)); }
                } else {
                    float sq = 0.f;
#pragma unroll
                    for (int bj = 0; bj < 2; ++bj) { const int col = (u.pn - 4) * BM + bj * HALF + cin;
                        const f32x4 a = gelu4(acc[ai][bj][m][0] * rs), b = gelu4(acc[ai][bj][m][1] * rs); sq += dot4(a) + dot4(b);
                        *(u32x4*)(V + (size_t)row * 768 + col) = pack8(a, b); }
                    sq += __shfl_xor(sq, 16); sq += __shfl_xor(sq, 32);
                    if (fq == 0) unsafeAtomicAdd(vss + row, sq);
                }
            }
    }
};
struct EpiS5a {
    float* S;
    __device__ __forceinline__ void operator()(Acc& acc, const Unit& u, int wr, int wc, int fr, int fq) const {
        const int row0 = u.pm * BM + wr * 64 + fr, cin = wc * 32 + 8 * fq;
#pragma unroll
        for (int ai = 0; ai < 2; ++ai)
#pragma unroll
            for (int m = 0; m < 4; ++m) { float* dst = S + (size_t)(row0 + ai * HALF + m * 16) * 128 + cin;
                *(f32x4*)dst = acc[ai][0][m][0]; *(f32x4*)(dst + 4) = acc[ai][0][m][1]; }
    }
};
struct EpiS5b {
    const bf16_t* UH; const float* dsk; bf16_t* Y1;
    __device__ __forceinline__ void operator()(Acc& acc, const Unit& u, int wr, int wc, int fr, int fq) const {
        const int row0 = u.pm * BM + wr * 64 + fr, cin = wc * 32 + 8 * fq;
        u32x4 uw[2][4][2]; f32x4 dv[2][2];
#pragma unroll
        for (int bj = 0; bj < 2; ++bj) { const int col = u.pn * BM + bj * HALF + cin, ch0 = col & 15, g = row0 >> 11;
            dv[bj][0] = *(const f32x4*)(dsk + g * 16 + ch0); dv[bj][1] = *(const f32x4*)(dsk + g * 16 + ch0 + 4);
#pragma unroll
            for (int ai = 0; ai < 2; ++ai)
#pragma unroll
                for (int m = 0; m < 4; ++m) uw[ai][m][bj] = *(const u32x4*)(UH + (size_t)(row0 + ai * HALF + m * 16) * 640 + col); }
        __builtin_amdgcn_sched_barrier(0);
#pragma unroll
        for (int ai = 0; ai < 2; ++ai)
#pragma unroll
            for (int m = 0; m < 4; ++m) {
                const int grow = row0 + ai * HALF + m * 16, g = grow >> 11, bc = grow & 2047;
#pragma unroll
                for (int bj = 0; bj < 2; ++bj) { const int col = u.pn * BM + bj * HALF + cin, jj = col >> 4, ch0 = col & 15;
                    f32x4 u0, u1; unpack8(uw[ai][m][bj], u0, u1);
                    const size_t tok = (size_t)(bc >> 7) * 4096 + (bc & 127) * 32 + jj;
                    *(u32x4*)(Y1 + tok * 256 + g * 16 + ch0) = pack8(gelu4(acc[ai][bj][m][0] + dv[bj][0] * u0), gelu4(acc[ai][bj][m][1] + dv[bj][1] * u1)); }
            }
    }
};
struct EpiGlu {
    const bf16_t* Y1; const float* bglu; bf16_t* MIX;
    __device__ __forceinline__ void operator()(Acc& acc, const Unit& u, int wr, int wc, int fr, int fq) const {
        const int row0 = u.pm * BM + wr * 64 + fr, cin = wc * 32 + 8 * fq;
        u32x4 yv[2][4][2]; f32x4 bv[2][2];
#pragma unroll
        for (int bj = 0; bj < 2; ++bj) { const int col = bj * HALF + cin; bv[bj][0] = *(const f32x4*)(bglu + col); bv[bj][1] = *(const f32x4*)(bglu + col + 4);
#pragma unroll
            for (int ai = 0; ai < 2; ++ai)
#pragma unroll
                for (int m = 0; m < 4; ++m) yv[ai][m][bj] = *(const u32x4*)(Y1 + (size_t)(row0 + ai * HALF + m * 16) * 256 + col); }
        __builtin_amdgcn_sched_barrier(0);
#pragma unroll
        for (int ai = 0; ai < 2; ++ai)
#pragma unroll
            for (int m = 0; m < 4; ++m) { const int row = row0 + ai * HALF + m * 16;
#pragma unroll
                for (int bj = 0; bj < 2; ++bj) { const int col = bj * HALF + cin;
                    f32x4 y0, y1; unpack8(yv[ai][m][bj], y0, y1);
                    const f32x4 z0 = acc[ai][bj][m][0] + bv[bj][0], z1 = acc[ai][bj][m][1] + bv[bj][1];
                    const f32x4 o0 = (f32x4){y0[0] * sigm(z0[0]), y0[1] * sigm(z0[1]), y0[2] * sigm(z0[2]), y0[3] * sigm(z0[3])};
                    const f32x4 o1 = (f32x4){y1[0] * sigm(z1[0]), y1[1] * sigm(z1[1]), y1[2] * sigm(z1[2]), y1[3] * sigm(z1[3])};
                    *(u32x4*)(MIX + (size_t)row * 1024 + col) = pack8(o0, o1); }
            }
    }
};
struct EpiRes {
    bf16_t* hb; float* ss;
    __device__ __forceinline__ void operator()(Acc& acc, const Unit& u, int wr, int wc, int fr, int fq) const {
        const int row0 = u.pm * BM + wr * 64 + fr, cin = u.pn * BM + wc * 32 + 8 * fq;
        bf16_t* hbp = hb + (size_t)row0 * 1024 + cin;
        u32x4 hv[2][4][2];
#pragma unroll
        for (int ai = 0; ai < 2; ++ai)
#pragma unroll
            for (int m = 0; m < 4; ++m)
#pragma unroll
                for (int bj = 0; bj < 2; ++bj) hv[ai][m][bj] = *(const u32x4*)(hbp + (size_t)(ai * HALF + m * 16) * 1024 + bj * HALF);
        __builtin_amdgcn_sched_barrier(0);
#pragma unroll
        for (int ai = 0; ai < 2; ++ai)
#pragma unroll
            for (int m = 0; m < 4; ++m) { const int row = row0 + ai * HALF + m * 16; float sq = 0.f;
#pragma unroll
                for (int bj = 0; bj < 2; ++bj) {
                    f32x4 a, b; unpack8(hv[ai][m][bj], a, b); a += acc[ai][bj][m][0]; b += acc[ai][bj][m][1];
                    *(u32x4*)(hbp + (size_t)(ai * HALF + m * 16) * 1024 + bj * HALF) = pack8(a, b); sq += dot4(a) + dot4(b); }
                sq += __shfl_xor(sq, 16); sq += __shfl_xor(sq, 32);
                if (fq == 0) unsafeAtomicAdd(ss + row, sq);
            }
    }
};
struct EpiFfnUp {
    const float* ss; const unsigned* cwt; bf16_t* G; unsigned* Ub;
    __device__ __forceinline__ void operator()(Acc& acc, const Unit& u, int wr, int wc, int fr, int fq) const {
        const int row0 = u.pm * BM + wr * 64 + fr;
        const float* ssr = ss + row0;
        const int ch0 = u.pn * HALF + wc * 32 + 8 * fq;
        const unsigned* cp = cwt + ch0;
        u32x4 pw[4][2];
#pragma unroll
        for (int k = 0; k < 4; ++k) { pw[k][0] = *(const u32x4*)(cp + k * 2816); pw[k][1] = *(const u32x4*)(cp + k * 2816 + 4); }
        unsigned gv[2][4][2][4];
#pragma unroll
        for (int ai = 0; ai < 2; ++ai)
#pragma unroll
            for (int m = 0; m < 4; ++m) { const float rs = rnorm(ssr[ai * HALF + m * 16]);
#pragma unroll
                for (int n = 0; n < 2; ++n) { const f32x4 gsv = acc[ai][0][m][n] * rs, vsv = acc[ai][1][m][n] * rs;
#pragma unroll
                    for (int j = 0; j < 4; ++j) gv[ai][m][n][j] = pk_h2(gsv[j], vsv[j]); } }
#pragma unroll
        for (int ai = 0; ai < 2; ++ai) { const int strip = u.pm * 4 + ai * 2 + wr;
            if (fr < 2) { unsigned* d = Ub + (size_t)(strip * 4 + fr) * 2816 + ch0;
                *(u32x4*)d = (u32x4){gv[ai][0][0][0], gv[ai][0][0][1], gv[ai][0][0][2], gv[ai][0][0][3]}; *(u32x4*)(d + 4) = (u32x4){gv[ai][0][1][0], gv[ai][0][1][1], gv[ai][0][1][2], gv[ai][0][1][3]}; }
            if (fr >= 14) { unsigned* d = Ub + (size_t)(strip * 4 + fr - 12) * 2816 + ch0;
                *(u32x4*)d = (u32x4){gv[ai][3][0][0], gv[ai][3][0][1], gv[ai][3][0][2], gv[ai][3][0][3]}; *(u32x4*)(d + 4) = (u32x4){gv[ai][3][1][0], gv[ai][3][1][1], gv[ai][3][1][2], gv[ai][3][1][3]}; }
        }
        const bool f1 = fr >= 1, f2 = fr >= 2;
        bf16_t* gp_ = G + (size_t)row0 * 2816 + ch0;
#pragma unroll
        for (int ai = 0; ai < 2; ++ai) {
            unsigned p1[2][4], p2[2][4];
#pragma unroll
            for (int n = 0; n < 2; ++n)
#pragma unroll
                for (int j = 0; j < 4; ++j) { p1[n][j] = 0u; p2[n][j] = 0u; }
#pragma unroll
            for (int m = 0; m < 4; ++m) {
                f32x4 o[2];
#pragma unroll
                for (int n = 0; n < 2; ++n)
#pragma unroll
                    for (int j = 0; j < 4; ++j) {
                        const unsigned cur = gv[ai][m][n][j];
                        const unsigned t1 = shr1_old(p1[n][j], cur), t2 = shr2_old(p2[n][j], cur);
                        if (m < 3) { p1[n][j] = ror1u(cur); p2[n][j] = ror2u(cur); }
                        h2_t c = as_h2(pw[2][n][j]) * as_h2(cur) + as_h2(pw[3][n][j]);
                        c = as_h2(pw[1][n][j]) * as_h2(t1) + c;
                        c = as_h2(pw[0][n][j]) * as_h2(t2) + c;
                        const float lo = (float)c.x, hi = (float)c.y;
                        o[n][j] = lo * hi * __builtin_amdgcn_rcpf(1.0f + __builtin_amdgcn_exp2f(lo));
                    }
                *(u32x4*)(gp_ + (size_t)(ai * HALF + m * 16) * 2816) = pack8(o[0], o[1]);
            }
        }
    }
};
struct EpiOdIn {
    const float* ss; bf16_t* BG; bf16_t* Z;
    __device__ __forceinline__ void operator()(Acc& acc, const Unit& u, int wr, int wc, int fr, int fq) const {
        const int row0 = u.pm * BM + wr * 64 + fr, cin = wc * 32 + 8 * fq;
        float rsv[2][4];
#pragma unroll
        for (int ai = 0; ai < 2; ++ai)
#pragma unroll
            for (int m = 0; m < 4; ++m) rsv[ai][m] = ss[row0 + ai * HALF + m * 16];
        __builtin_amdgcn_sched_barrier(0);
#pragma unroll
        for (int ai = 0; ai < 2; ++ai)
#pragma unroll
            for (int m = 0; m < 4; ++m) { const int row = row0 + ai * HALF + m * 16; const float rs = rnorm(rsv[ai][m]);
                if (u.pn < 4) {
#pragma unroll
                    for (int bj = 0; bj < 2; ++bj) *(u32x4*)(BG + (size_t)row * 1024 + u.pn * BM + bj * HALF + cin) = pack8(acc[ai][bj][m][0] * rs, acc[ai][bj][m][1] * rs);
                } else { const float r2 = rs * rs;
                    *(u32x4*)(Z + (size_t)row * 1024 + (u.pn - 4) * HALF + cin) = pack8(acc[ai][0][m][0] * acc[ai][1][m][0] * r2, acc[ai][0][m][1] * acc[ai][1][m][1] * r2); }
            }
    }
};

template <class Epi> __device__ __forceinline__ void run_gemm(LAS unsigned char* lds, const bf16_t* A, const bf16_t* Bt, int M, int N, int K, int lda, int bgt, size_t bgs, const Epi& E) {
    Gemm g; g.A = A; g.Bt = Bt; g.M = M; g.N = N; g.K = K; g.lda = lda; g.bgt = bgt; g.bgs = bgs;
    int c_ = (int)blockIdx.x, G_ = (int)gridDim.x; asm volatile("" : "+s"(c_), "+s"(G_));
    StaticOrder S; S.init(M, N, G_, c_);
    gemm_phase<Epi>(lds, g, S, E);
}

__device__ __forceinline__ int rowmap(int mode, int n) {
    if (mode == 1) { const int bj = n >= 2816 ? 1 : 0, c = n - bj * 2816; return (c >> 7) * 256 + bj * 128 + (c & 127); }
    if (mode == 2) { if (n < 1024) return n; int c = n - 1024; const int bj = c >= 1024 ? 1 : 0; c -= bj * 1024; return 1024 + (c >> 7) * 256 + bj * 128 + (c & 127); }
    return n;
}
__device__ __forceinline__ void tr_job(const float* __restrict__ W, int K, int N, const float* __restrict__ gain, bf16_t* __restrict__ out, int mode, LAS float* lds_f, int gwave, int gwaves, int wid, int lane) {
    LAS float* tile = lds_f + wid * (32 * 65);
    const int tn = N >> 6, ntile = (K >> 5) * tn, r4 = lane >> 4, nn = (lane & 15) * 4;
    for (int t = gwave; t < ntile; t += gwaves) {
        const int k0 = (t / tn) << 5, n0 = (t % tn) << 6;
        f32x4 v[8];
#pragma unroll
        for (int i = 0; i < 8; ++i) v[i] = *(const f32x4*)(W + (size_t)(k0 + r4 + 4 * i) * N + n0 + nn);
#pragma unroll
        for (int i = 0; i < 8; ++i) { const int kk = r4 + 4 * i; const float gs = gain ? gain[k0 + kk] : 1.0f;
            tile[kk * 65 + nn] = v[i][0] * gs; tile[kk * 65 + nn + 1] = v[i][1] * gs; tile[kk * 65 + nn + 2] = v[i][2] * gs; tile[kk * 65 + nn + 3] = v[i][3] * gs; }
        asm volatile("s_waitcnt lgkmcnt(0)" ::: "memory");
        bf16_t* orow = out + (size_t)rowmap(mode, n0 + lane) * K + k0;
#pragma unroll
        for (int q = 0; q < 4; ++q) {
            const float f0 = tile[(q * 8 + 0) * 65 + lane], f1 = tile[(q * 8 + 1) * 65 + lane], f2 = tile[(q * 8 + 2) * 65 + lane], f3 = tile[(q * 8 + 3) * 65 + lane];
            const float f4 = tile[(q * 8 + 4) * 65 + lane], f5 = tile[(q * 8 + 5) * 65 + lane], f6 = tile[(q * 8 + 6) * 65 + lane], f7 = tile[(q * 8 + 7) * 65 + lane];
            u32x4 w; w.x = cvt_pk_bf16(f0, f1); w.y = cvt_pk_bf16(f2, f3); w.z = cvt_pk_bf16(f4, f5); w.w = cvt_pk_bf16(f6, f7);
            *(u32x4*)(orow + q * 8) = w; }
        asm volatile("s_waitcnt lgkmcnt(0)" ::: "memory");
    }
}
__device__ __forceinline__ void s5_apow(const Params& p, int g, int pp, float n, float& re, float& im) {
    const float lr = fminf(p.lam_re[g * 64 + pp], -1e-4f), li = p.lam_im[g * 64 + pp], dt = expf(p.log_dt[g]);
    const float mag = expf(lr * dt * n), th = li * dt * n; re = mag * cosf(th); im = mag * sinf(th);
}
__device__ __forceinline__ void s5_z(const Params& p, int g, int pp, float& zr, float& zi) {
    const float lr = fminf(p.lam_re[g * 64 + pp], -1e-4f), li = p.lam_im[g * 64 + pp];
    float ar, ai; s5_apow(p, g, pp, 1.0f, ar, ai);
    const float den = lr * lr + li * li, nr = ar - 1.0f, ni = ai;
    zr = (nr * lr + ni * li) / den; zi = (ni * lr - nr * li) / den;
}

__device__ __forceinline__ Params load_params() {
    Params p{};
#if defined(__HIP_DEVICE_COMPILE__)
    const __attribute__((address_space(4))) unsigned long long* q = (const __attribute__((address_space(4))) unsigned long long*)__builtin_amdgcn_kernarg_segment_ptr();
    asm volatile("" : "+s"(q));
    p.x = (const float*)(const __attribute__((address_space(1))) float*)q[0]; p.mix_g = (const float*)(const __attribute__((address_space(1))) float*)q[1]; p.ffn_g = (const float*)(const __attribute__((address_space(1))) float*)q[2]; p.fin_g = (const float*)(const __attribute__((address_space(1))) float*)q[3]; p.ev_w_in = (const float*)(const __attribute__((address_space(1))) float*)q[4]; p.ev_w_out = (const float*)(const __attribute__((address_space(1))) float*)q[5]; p.lam_re = (const float*)(const __attribute__((address_space(1))) float*)q[6]; p.lam_im = (const float*)(const __attribute__((address_space(1))) float*)q[7]; p.log_dt = (const float*)(const __attribute__((address_space(1))) float*)q[8]; p.b_re = (const float*)(const __attribute__((address_space(1))) float*)q[9]; p.b_im = (const float*)(const __attribute__((address_space(1))) float*)q[10]; p.c_re = (const float*)(const __attribute__((address_space(1))) float*)q[11]; p.c_im = (const float*)(const __attribute__((address_space(1))) float*)q[12]; p.s5_d = (const float*)(const __attribute__((address_space(1))) float*)q[13]; p.w_glu = (const float*)(const __attribute__((address_space(1))) float*)q[14]; p.b_glu = (const float*)(const __attribute__((address_space(1))) float*)q[15]; p.gm_ws = (const float*)(const __attribute__((address_space(1))) float*)q[16]; p.gm_bs = (const float*)(const __attribute__((address_space(1))) float*)q[17]; p.gm_vg = (const float*)(const __attribute__((address_space(1))) float*)q[18]; p.od_w_in = (const float*)(const __attribute__((address_space(1))) float*)q[19]; p.od_cw = (const float*)(const __attribute__((address_space(1))) float*)q[20]; p.od_cb = (const float*)(const __attribute__((address_space(1))) float*)q[21]; p.od_w_out = (const float*)(const __attribute__((address_space(1))) float*)q[22]; p.ffn_up = (const float*)(const __attribute__((address_space(1))) float*)q[23]; p.ffn_cw = (const float*)(const __attribute__((address_space(1))) float*)q[24]; p.ffn_cb = (const float*)(const __attribute__((address_space(1))) float*)q[25]; p.ffn_dn = (const float*)(const __attribute__((address_space(1))) float*)q[26]; p.out = (float*)(__attribute__((address_space(1))) float*)q[27]; p.ws = (unsigned char*)(__attribute__((address_space(1))) unsigned char*)q[28];
#endif
    return p;
}
#define PHASE_PTRS const Params p = load_params(); unsigned char* ws = p.ws; bf16_t* WIN0 = (bf16_t*)(ws + O_WIN0); bf16_t* WOUT0 = (bf16_t*)(ws + O_WOUT0); bf16_t* WODIN = (bf16_t*)(ws + O_WODIN); bf16_t* WODOUT = (bf16_t*)(ws + O_WODOUT); bf16_t* WGLU = (bf16_t*)(ws + O_WGLU); bf16_t* M1T = (bf16_t*)(ws + O_M1T); bf16_t* T2T = (bf16_t*)(ws + O_T2T); bf16_t* WSB = (bf16_t*)(ws + O_WSB); float* KTAB = (float*)(ws + O_KTAB); float* SS = (float*)(ws + O_SS); float* ss0 = SS; float* ssf0 = SS + 65536; float* ssm1 = SS + 2 * 65536; float* ssf1 = SS + 3 * 65536; float* ssfin = SS + 4 * 65536; float* vss = SS + 5 * 65536; bf16_t* HB = (bf16_t*)(ws + O_HB); bf16_t* UH = (bf16_t*)(ws + O_UH); float* Sst = (float*)(ws + O_S); bf16_t* Ub_ = (bf16_t*)(ws + O_U); bf16_t* Vb = (bf16_t*)(ws + O_V); bf16_t* Y1 = (bf16_t*)(ws + O_Y1); bf16_t* MIX = (bf16_t*)(ws + O_MIX); bf16_t* BG = (bf16_t*)(ws + O_BG); bf16_t* Zb = (bf16_t*)(ws + O_Z); bf16_t* Gb = (bf16_t*)(ws + O_G); bf16_t* UB = (bf16_t*)(ws + O_UB); (void)WIN0; (void)WOUT0; (void)WODIN; (void)WODOUT; (void)WGLU; (void)M1T; (void)T2T; (void)WSB; (void)KTAB; (void)ss0; (void)ssf0; (void)ssm1; (void)ssf1; (void)ssfin; (void)vss; (void)HB; (void)UH; (void)Sst; (void)Ub_; (void)Vb; (void)Y1; (void)MIX; (void)BG; (void)Zb; (void)Gb; (void)UB;
#define PHASE_IDS int tid = threadIdx.x; asm volatile("" : "+v"(tid)); const int lane = tid & 63, wid = tid >> 6, gtid = blockIdx.x * 512 + tid, gthreads = gridDim.x * 512, gwave = blockIdx.x * 8 + wid, gwaves = gridDim.x * 8; (void)lane; (void)wid; (void)gtid; (void)gthreads; (void)gwave; (void)gwaves;
#define XB_TMO      128
#define XB_XCNT(j)  (256  + 64 * (j))
#define XB_XSUB(j)  (1280 + 64 * (j))
#define XB_XGEN(j)  (2304 + 64 * (j))
#define XB_TOP      3328
#define XB_TOPGEN   3392
#define XCD_BAR_WORDS 3456
#define XB_SPIN_CAP (1u << 20)
__device__ __forceinline__ unsigned xb_ld(unsigned* p)              { return __hip_atomic_load(p, __ATOMIC_RELAXED, __HIP_MEMORY_SCOPE_AGENT); }
__device__ __forceinline__ unsigned xb_add(unsigned* p, unsigned v) { return __hip_atomic_fetch_add(p, v, __ATOMIC_RELAXED, __HIP_MEMORY_SCOPE_AGENT); }
__device__ __forceinline__ unsigned xb_xcc_id() { return (unsigned)__builtin_amdgcn_s_getreg((3 << 11) | 20) & 0xFu; }
#define XB_SPIN(cond, bar) do { unsigned _sp = 0; while (cond) { __builtin_amdgcn_s_sleep(1); \
    if ((++_sp & 255u) == 0u) { if (xb_ld(&(bar)[XB_TMO])) break; if (_sp > XB_SPIN_CAP) { atomicAdd(&(bar)[XB_TMO], 1u); break; } } } } while (0)
__device__ __forceinline__ void xcd_barrier_complete(unsigned* bar, unsigned x, unsigned& nloc, unsigned& nx) {
    const unsigned G = gridDim.x * gridDim.y * gridDim.z;
    unsigned sum, cnt, mine, sp = 0u;
    for (;;) {
        sum = 0u; cnt = 0u; mine = 0u;
#pragma unroll
        for (unsigned j = 0; j < 16; ++j) { const unsigned c = xb_ld(&bar[XB_XCNT(j)]); sum += c; cnt += (c > 0u) ? 1u : 0u; mine = (j == x) ? c : mine; }
        if (sum == G) break;
        __builtin_amdgcn_s_sleep(1);
        if ((++sp & 255u) == 0u) { if (xb_ld(&bar[XB_TMO])) break; if (sp > XB_SPIN_CAP) { atomicAdd(&bar[XB_TMO], 1u); break; } }
    }
    nloc = mine > 0u ? mine : 1u; nx = cnt > 0u ? cnt : 1u;
}
__device__ __forceinline__ void xcd_barrier(unsigned* bar, volatile LAS unsigned* st) {
    asm volatile("s_waitcnt vmcnt(0)" ::: "memory");
    __syncthreads();
    int tid = threadIdx.x; asm volatile("" : "+v"(tid));
    if (tid == 0) {
        const unsigned x = xb_xcc_id();
        __builtin_amdgcn_s_waitcnt(0);
        unsigned nloc = st[0], nx = st[1];
        if (nloc == 0u) { xcd_barrier_complete(bar, x, nloc, nx); st[0] = nloc; st[1] = nx; }
        const unsigned old = xb_add(&bar[XB_XSUB(x)], 1u);
        const unsigned gen = old / nloc;
        if (old + 1u == (gen + 1u) * nloc) {
            __builtin_amdgcn_fence(__ATOMIC_RELEASE, "agent");
            asm volatile("s_waitcnt vmcnt(0)" ::: "memory");
            const unsigned og = xb_add(&bar[XB_TOP], 1u);
            const unsigned tg = og / nx;
            if (og + 1u == (tg + 1u) * nx) xb_add(&bar[XB_TOPGEN], 1u);
            else XB_SPIN(xb_ld(&bar[XB_TOPGEN]) == tg, bar);
            __builtin_amdgcn_fence(__ATOMIC_ACQUIRE, "agent");
            xb_add(&bar[XB_XGEN(x)], 1u);
            asm volatile("s_waitcnt vmcnt(0)" ::: "memory");
        } else {
            XB_SPIN(xb_ld(&bar[XB_XGEN(x)]) == gen, bar);
            __builtin_amdgcn_fence(__ATOMIC_ACQUIRE, "agent");
            asm volatile("s_waitcnt vmcnt(0)" ::: "memory");
        }
    }
    __syncthreads();
}
#define GRID_BAR() do { PHASE_PTRS xcd_barrier((unsigned*)(ws + O_BAR), (volatile LAS unsigned*)(lds + STAGE_BYTES)); } while (0)
template <int layer> __device__ __forceinline__ void layer_body(LAS unsigned char* lds, unsigned& nbar) {
        if constexpr (layer == 0) {
            { PHASE_PTRS EpiIn0 e; e.ss = ss0; e.UH = UH; e.U = Ub_; e.V = Vb; e.vss = vss; run_gemm(lds, HB, WIN0, MTOK, 1792, 1024, 1024, 0, 0, e); }
            GRID_BAR();
            { PHASE_PTRS EpiS5a e; e.S = Sst; run_gemm(lds, UH, M1T, 32768, 256, 512, 640, 8, (size_t)256 * 512 * 2, e); }
            {
                PHASE_PTRS PHASE_IDS
                LAS bf16_t* VT = (LAS bf16_t*)lds;
                const int fr = lane & 15, fq = lane >> 4, ta = wid >> 1, cbk = wid & 1;
                int u0, u1;
                if (gridDim.x == 256) { if (blockIdx.x < 128) { u0 = 10 * (int)blockIdx.x; u1 = u0 + 10; } else { u0 = 1280 + 14 * ((int)blockIdx.x - 128); u1 = u0 + 14; } }
                else { const int per = (3072 + (int)gridDim.x - 1) / (int)gridDim.x; u0 = per * (int)blockIdx.x; u1 = u0 + per < 3072 ? u0 + per : 3072; }
                const int sg = tid & 31, cgp = tid >> 5;
                u32x4 raw[4]; float vs4[4];
#pragma unroll
                for (int r = 0; r < 4; ++r) { raw[r] = (u32x4){0u, 0u, 0u, 0u}; vs4[r] = 1.0f; }
                f32x4 gvn[4]; u32x2 uwn[2][4]; float bsn[2];
#pragma unroll
                for (int nc = 0; nc < 4; ++nc) gvn[nc] = (f32x4){0.f, 0.f, 0.f, 0.f};
#pragma unroll
                for (int mt = 0; mt < 2; ++mt) { bsn[mt] = 0.f;
#pragma unroll
                    for (int nc = 0; nc < 4; ++nc) uwn[mt][nc] = (u32x2){0u, 0u}; }
                if (u0 < u1) { const int h = u0 % 6, tok0 = (u0 / 6) * 128;
#pragma unroll
                    for (int r = 0; r < 4; ++r) { raw[r] = *(const u32x4*)(Vb + (size_t)(tok0 + 4 * sg + r) * 768 + h * 128 + cgp * 8); vs4[r] = vss[tok0 + 4 * sg + r]; }
#pragma unroll
                    for (int nc = 0; nc < 4; ++nc) gvn[nc] = *(const f32x4*)(p.gm_vg + h * 128 + 64 * cbk + 16 * nc + 4 * fq);
#pragma unroll
                    for (int mt = 0; mt < 2; ++mt) { const int t = 32 * ta + 16 * mt + fr; bsn[mt] = p.gm_bs[h * 128 + t];
#pragma unroll
                        for (int nc = 0; nc < 4; ++nc) uwn[mt][nc] = *(const u32x2*)(Ub_ + (size_t)(tok0 + t) * 768 + h * 128 + 64 * cbk + 16 * nc + 4 * fq); } }
                for (int un = u0; un < u1; ++un) {
                    const int h = un % 6, bn = un / 6, tok0 = bn * 128;
                    bf16x8 afv[4][2];
#pragma unroll
                    for (int ks = 0; ks < 4; ++ks) if (ks <= ta) {
#pragma unroll
                        for (int mt = 0; mt < 2; ++mt) afv[ks][mt] = *(const bf16x8*)(WSB + ((size_t)(h * 128 + 32 * ta + 16 * mt + fr) * 128 + 32 * ks + 8 * fq)); }
                    asm volatile("s_waitcnt lgkmcnt(0)" ::: "memory"); __builtin_amdgcn_s_barrier(); asm volatile("" ::: "memory");
                    { u32x4 w[4];
#pragma unroll
                      for (int r = 0; r < 4; ++r) { const float rv = rsqrtf(vs4[r] * (1.0f / 768.0f) + EPS); f32x4 a, b; unpack8(raw[r], a, b); a *= rv; b *= rv; w[r] = pack8(a, b); }
                      LAS bf16_t* d = VT + (cgp * 8) * 136 + 4 * sg;
#pragma unroll
                      for (int di = 0; di < 4; ++di) {
                          const unsigned x0 = w[0][di], x1 = w[1][di], x2 = w[2][di], x3 = w[3][di];
                          *(LAS u32x2*)(d + (2 * di) * 136) = (u32x2){(x0 & 0xffffu) | (x1 << 16), (x2 & 0xffffu) | (x3 << 16)};
                          *(LAS u32x2*)(d + (2 * di + 1) * 136) = (u32x2){(x0 >> 16) | (x1 & 0xffff0000u), (x2 >> 16) | (x3 & 0xffff0000u)}; } }
                    asm volatile("s_waitcnt lgkmcnt(0)" ::: "memory"); __builtin_amdgcn_s_barrier(); asm volatile("" ::: "memory");
                    f32x4 gvv[4]; u32x2 uwv[2][4]; float bsv[2];
#pragma unroll
                    for (int nc = 0; nc < 4; ++nc) gvv[nc] = gvn[nc];
#pragma unroll
                    for (int mt = 0; mt < 2; ++mt) { bsv[mt] = bsn[mt];
#pragma unroll
                        for (int nc = 0; nc < 4; ++nc) uwv[mt][nc] = uwn[mt][nc]; }
                    if (un + 1 < u1) { const int h2 = (un + 1) % 6, tok2 = ((un + 1) / 6) * 128;
#pragma unroll
                        for (int r = 0; r < 4; ++r) { raw[r] = *(const u32x4*)(Vb + (size_t)(tok2 + 4 * sg + r) * 768 + h2 * 128 + cgp * 8); vs4[r] = vss[tok2 + 4 * sg + r]; }
#pragma unroll
                        for (int nc = 0; nc < 4; ++nc) gvn[nc] = *(const f32x4*)(p.gm_vg + h2 * 128 + 64 * cbk + 16 * nc + 4 * fq);
#pragma unroll
                        for (int mt = 0; mt < 2; ++mt) { const int t = 32 * ta + 16 * mt + fr; bsn[mt] = p.gm_bs[h2 * 128 + t];
#pragma unroll
                            for (int nc = 0; nc < 4; ++nc) uwn[mt][nc] = *(const u32x2*)(Ub_ + (size_t)(tok2 + t) * 768 + h2 * 128 + 64 * cbk + 16 * nc + 4 * fq); } }
                    f32x4 acc[2][4];
#pragma unroll
                    for (int a = 0; a < 2; ++a)
#pragma unroll
                        for (int b = 0; b < 4; ++b) acc[a][b] = (f32x4){0.f, 0.f, 0.f, 0.f};
#pragma unroll
                    for (int ks = 0; ks < 4; ++ks) if (ks <= ta) {
                        bf16x8 bfr[4];
#pragma unroll
                        for (int nc = 0; nc < 4; ++nc) bfr[nc] = *(const LAS bf16x8*)(VT + (64 * cbk + 16 * nc + fr) * 136 + 32 * ks + 8 * fq);
#pragma unroll
                        for (int mt = 0; mt < 2; ++mt)
#pragma unroll
                            for (int nc = 0; nc < 4; ++nc) acc[mt][nc] = __builtin_amdgcn_mfma_f32_16x16x32_bf16(bfr[nc], afv[ks][mt], acc[mt][nc], 0, 0, 0);
                    }
#pragma unroll
                    for (int mt = 0; mt < 2; ++mt) { const int t = 32 * ta + 16 * mt + fr; const float bs = bsv[mt];
#pragma unroll
                        for (int nc = 0; nc < 4; ++nc) { const int c = h * 128 + 64 * cbk + 16 * nc + 4 * fq;
                            const f32x4 gv = gvv[nc]; const u32x2 uw = uwv[mt][nc];
                            const f32x4 gate = acc[mt][nc] * gv + bs;
                            const u32x2 o = (u32x2){cvt_pk_bf16(bflo(uw.x) * gate[0], bfhi(uw.x) * gate[1]), cvt_pk_bf16(bflo(uw.y) * gate[2], bfhi(uw.y) * gate[3])};
                            *(u32x2*)(MIX + (size_t)(tok0 + t) * 1024 + 256 + c) = o; } }
                }
                __syncthreads();
            }
            GRID_BAR();
            { PHASE_PTRS PHASE_IDS
              LAS float* Eseg = (LAS float*)lds;
              for (int gb = blockIdx.x; gb < 256; gb += gridDim.x) { const int g = gb >> 4, b = gb & 15, pp = lane;
                  float ar, ai; s5_apow(p, g, pp, 32.0f, ar, ai);
                  const size_t row0 = (size_t)g * 2048 + b * 128 + wid * 16;
                  float lr[16], li[16], sr[16], si[16];
#pragma unroll
                  for (int i = 0; i < 16; ++i) { sr[i] = Sst[(row0 + i) * 128 + pp]; si[i] = Sst[(row0 + i) * 128 + 64 + pp]; }
                  float hr = 0.f, hi_ = 0.f;
#pragma unroll
                  for (int i = 0; i < 16; ++i) { lr[i] = hr; li[i] = hi_; const float nr = ar * hr - ai * hi_ + sr[i], ni = ar * hi_ + ai * hr + si[i]; hr = nr; hi_ = ni; }
                  __syncthreads();
                  Eseg[(wid * 64 + pp) * 2] = hr; Eseg[(wid * 64 + pp) * 2 + 1] = hi_;
                  __syncthreads();
                  float br, bi; s5_apow(p, g, pp, 512.0f, br, bi);
                  float cr = 0.f, ci = 0.f;
                  for (int w2 = 0; w2 < wid; ++w2) { const float er = Eseg[(w2 * 64 + pp) * 2], ei = Eseg[(w2 * 64 + pp) * 2 + 1];
                      const float nr = br * cr - bi * ci + er, ni = br * ci + bi * cr + ei; cr = nr; ci = ni; }
#pragma unroll
                  for (int i = 0; i < 16; ++i) {
                      UH[(row0 + i) * 640 + 512 + pp] = (bf16_t)(cvt_pk_bf16(lr[i] + cr, 0.f) & 0xffffu); UH[(row0 + i) * 640 + 512 + 64 + pp] = (bf16_t)(cvt_pk_bf16(li[i] + ci, 0.f) & 0xffffu);
                      const float nr = ar * cr - ai * ci, ni = ar * ci + ai * cr; cr = nr; ci = ni; }
              }
              __syncthreads();
            }
            GRID_BAR();
            { PHASE_PTRS EpiS5b e; e.UH = UH; e.dsk = p.s5_d; e.Y1 = Y1; run_gemm(lds, UH, T2T, 32768, 512, 640, 640, 8, (size_t)512 * 640 * 2, e); }
            GRID_BAR();
            { PHASE_PTRS EpiGlu e; e.Y1 = Y1; e.bglu = p.b_glu; e.MIX = MIX; run_gemm(lds, Y1, WGLU, MTOK, 256, 256, 256, 0, 0, e); }
            GRID_BAR();
        } else {
            { PHASE_PTRS EpiOdIn e; e.ss = ssm1; e.BG = BG; e.Z = Zb; run_gemm(lds, HB, WODIN, MTOK, 3072, 1024, 1024, 0, 0, e); }
            GRID_BAR();
            { PHASE_PTRS PHASE_IDS
              const int c8 = (gtid & 127) * 8;
              const float* cw = p.od_cw; const float* cb = p.od_cb;
              const f32x4 w00 = *(const f32x4*)(cw + c8), w01 = *(const f32x4*)(cw + c8 + 4), w10 = *(const f32x4*)(cw + 1024 + c8), w11 = *(const f32x4*)(cw + 1024 + c8 + 4);
              const f32x4 w20 = *(const f32x4*)(cw + 2048 + c8), w21 = *(const f32x4*)(cw + 2048 + c8 + 4), bb0 = *(const f32x4*)(cb + c8), bb1 = *(const f32x4*)(cb + c8 + 4);
              const int tstep = gthreads >> 7;
              for (int tok = gtid >> 7; tok < MTOK; tok += 2 * tstep) {
                  u32x4 rz0[2], rz1[2], rz2[2], rbg[2]; bool ok[2];
#pragma unroll
                  for (int q = 0; q < 2; ++q) { const int tk = tok + q * tstep; ok[q] = tk < MTOK; const int t = tk & 4095; const size_t off = (size_t)tk * 1024 + c8;
                      rz0[q] = rz1[q] = rz2[q] = rbg[q] = (u32x4){0u, 0u, 0u, 0u};
                      if (ok[q]) { rz0[q] = *(const u32x4*)(Zb + off); rbg[q] = *(const u32x4*)(BG + off);
                          if (t >= 1) rz1[q] = *(const u32x4*)(Zb + off - 1024);
                          if (t >= 2) rz2[q] = *(const u32x4*)(Zb + off - 2048); } }
#pragma unroll
                  for (int q = 0; q < 2; ++q) { if (!ok[q]) continue; const size_t off = (size_t)(tok + q * tstep) * 1024 + c8;
                      f32x4 z0a, z0b, z1a, z1b, z2a, z2b, ga, gb_;
                      unpack8(rz0[q], z0a, z0b); unpack8(rz1[q], z1a, z1b); unpack8(rz2[q], z2a, z2b); unpack8(rbg[q], ga, gb_);
                      const f32x4 oa = ga * (bb0 + w00 * z2a + w10 * z1a + w20 * z0a), ob = gb_ * (bb1 + w01 * z2b + w11 * z1b + w21 * z0b);
                      *(u32x4*)(MIX + off) = pack8(oa, ob); }
              }
            }
            GRID_BAR();
        }
        { PHASE_PTRS EpiRes e; e.hb = HB; e.ss = layer == 0 ? ssf0 : ssf1;
          run_gemm(lds, MIX, layer == 0 ? WOUT0 : WODOUT, MTOK, 1024, 1024, 1024, 0, 0, e); }
        GRID_BAR();
        { PHASE_PTRS EpiFfnUp e; e.ss = layer == 0 ? ssf0 : ssf1; e.cwt = (const unsigned*)(ws + O_CWT) + (size_t)layer * 4 * 2816; e.G = Gb; e.Ub = (unsigned*)UB;
          run_gemm(lds, HB, (const bf16_t*)(ws + O_WUP + (size_t)layer * SZ_WUP), MTOK, 5632, 1024, 1024, 0, 0, e); }
        GRID_BAR();
        { PHASE_PTRS PHASE_IDS
        const float* fcw = p.ffn_cw + (size_t)layer * 3 * 5632; const float* fcb = p.ffn_cb + (size_t)layer * 5632;
        const int nth = (gthreads / 352) * 352, rstep = nth / 352;
        if (gtid < nth) {
        const int ch = (gtid % 352) * 8;
        const f32x4 tb_ga = *(const f32x4*)(fcb + ch), tb_gb = *(const f32x4*)(fcb + ch + 4), tb_va = *(const f32x4*)(fcb + 2816 + ch), tb_vb = *(const f32x4*)(fcb + 2816 + ch + 4);
        const f32x4 t0_ga = *(const f32x4*)(fcw + ch), t0_gb = *(const f32x4*)(fcw + ch + 4), t0_va = *(const f32x4*)(fcw + 2816 + ch), t0_vb = *(const f32x4*)(fcw + 2816 + ch + 4);
        const f32x4 t1_ga = *(const f32x4*)(fcw + 5632 + ch), t1_gb = *(const f32x4*)(fcw + 5632 + ch + 4), t1_va = *(const f32x4*)(fcw + 5632 + 2816 + ch), t1_vb = *(const f32x4*)(fcw + 5632 + 2816 + ch + 4);
        const f32x4 t2_ga = *(const f32x4*)(fcw + 2 * 5632 + ch), t2_gb = *(const f32x4*)(fcw + 2 * 5632 + ch + 4), t2_va = *(const f32x4*)(fcw + 2 * 5632 + 2816 + ch), t2_vb = *(const f32x4*)(fcw + 2 * 5632 + 2816 + ch + 4);
        for (int it = gtid / 352; it < 2048; it += rstep) { const int r = it & 1, k = it >> 1;
            if ((k & 63) == 0) continue;
            const unsigned* UBu = (const unsigned*)UB;
            const unsigned* cur = UBu + (size_t)(k * 4 + r) * 2816 + ch; const unsigned* m1 = (r == 0 ? UBu + (size_t)((k - 1) * 4 + 3) * 2816 : UBu + (size_t)(k * 4) * 2816) + ch;
            const unsigned* m2 = (r == 0 ? UBu + (size_t)((k - 1) * 4 + 2) * 2816 : UBu + (size_t)((k - 1) * 4 + 3) * 2816) + ch;
            f32x4 g0a, g0b, g1a, g1b, g2a, g2b, v0a, v0b, v1a, v1b, v2a, v2b;
            { const u32x4 x0 = *(const u32x4*)cur, x1 = *(const u32x4*)(cur + 4);
              g0a = (f32x4){(float)as_h2(x0.x).x, (float)as_h2(x0.y).x, (float)as_h2(x0.z).x, (float)as_h2(x0.w).x}; v0a = (f32x4){(float)as_h2(x0.x).y, (float)as_h2(x0.y).y, (float)as_h2(x0.z).y, (float)as_h2(x0.w).y};
              g0b = (f32x4){(float)as_h2(x1.x).x, (float)as_h2(x1.y).x, (float)as_h2(x1.z).x, (float)as_h2(x1.w).x}; v0b = (f32x4){(float)as_h2(x1.x).y, (float)as_h2(x1.y).y, (float)as_h2(x1.z).y, (float)as_h2(x1.w).y}; }
            { const u32x4 x0 = *(const u32x4*)m1, x1 = *(const u32x4*)(m1 + 4);
              g1a = (f32x4){(float)as_h2(x0.x).x, (float)as_h2(x0.y).x, (float)as_h2(x0.z).x, (float)as_h2(x0.w).x}; v1a = (f32x4){(float)as_h2(x0.x).y, (float)as_h2(x0.y).y, (float)as_h2(x0.z).y, (float)as_h2(x0.w).y};
              g1b = (f32x4){(float)as_h2(x1.x).x, (float)as_h2(x1.y).x, (float)as_h2(x1.z).x, (float)as_h2(x1.w).x}; v1b = (f32x4){(float)as_h2(x1.x).y, (float)as_h2(x1.y).y, (float)as_h2(x1.z).y, (float)as_h2(x1.w).y}; }
            { const u32x4 x0 = *(const u32x4*)m2, x1 = *(const u32x4*)(m2 + 4);
              g2a = (f32x4){(float)as_h2(x0.x).x, (float)as_h2(x0.y).x, (float)as_h2(x0.z).x, (float)as_h2(x0.w).x}; v2a = (f32x4){(float)as_h2(x0.x).y, (float)as_h2(x0.y).y, (float)as_h2(x0.z).y, (float)as_h2(x0.w).y};
              g2b = (f32x4){(float)as_h2(x1.x).x, (float)as_h2(x1.y).x, (float)as_h2(x1.z).x, (float)as_h2(x1.w).x}; v2b = (f32x4){(float)as_h2(x1.x).y, (float)as_h2(x1.y).y, (float)as_h2(x1.z).y, (float)as_h2(x1.w).y}; }
            const f32x4 cga = tb_ga + t0_ga * g2a + t1_ga * g1a + t2_ga * g0a;
            const f32x4 cgb = tb_gb + t0_gb * g2b + t1_gb * g1b + t2_gb * g0b;
            const f32x4 cva = tb_va + t0_va * v2a + t1_va * v1a + t2_va * v0a;
            const f32x4 cvb = tb_vb + t0_vb * v2b + t1_vb * v1b + t2_vb * v0b;
            const f32x4 oa = (f32x4){cga[0] * sigm(cga[0]) * cva[0], cga[1] * sigm(cga[1]) * cva[1], cga[2] * sigm(cga[2]) * cva[2], cga[3] * sigm(cga[3]) * cva[3]};
            const f32x4 ob = (f32x4){cgb[0] * sigm(cgb[0]) * cvb[0], cgb[1] * sigm(cgb[1]) * cvb[1], cgb[2] * sigm(cgb[2]) * cvb[2], cgb[3] * sigm(cgb[3]) * cvb[3]};
            *(u32x4*)(Gb + (size_t)(k * 64 + r) * 2816 + ch) = pack8(oa, ob); } } }
        GRID_BAR();
        { PHASE_PTRS EpiRes e; e.hb = HB; e.ss = layer == 0 ? ssm1 : ssfin;
          run_gemm(lds, Gb, (const bf16_t*)(ws + O_WDN + (size_t)layer * SZ_WDN), MTOK, 1024, 2816, 2816, 0, 0, e); }
        GRID_BAR();
}
__global__ void __launch_bounds__(512, 2) fwd_kernel(Params p_arg) {
    extern __shared__ __attribute__((aligned(16))) unsigned char shm[];
    LAS unsigned char* lds = (LAS unsigned char*)shm;
    cg::grid_group grid = cg::this_grid();
    unsigned nbar = 0;
    {
        PHASE_PTRS
        volatile LAS unsigned* st = (volatile LAS unsigned*)(lds + STAGE_BYTES);
        int t0 = threadIdx.x; asm volatile("" : "+v"(t0));
        if (t0 == 0) { st[0] = 0u; st[1] = 0u; (void)xb_add(&((unsigned*)(ws + O_BAR))[XB_XCNT(xb_xcc_id())], 1u); }
        __syncthreads();
    }

    {
        PHASE_PTRS PHASE_IDS
        LAS float* tile = (LAS float*)lds;
        tr_job(p.ev_w_in, 1024, 1792, p.mix_g, WIN0, 0, tile, gwave, gwaves, wid, lane);
        tr_job(p.ev_w_out, 1024, 1024, nullptr, WOUT0, 0, tile, gwave, gwaves, wid, lane);
        tr_job(p.ffn_up, 1024, 5632, p.ffn_g, (bf16_t*)(ws + O_WUP), 1, tile, gwave, gwaves, wid, lane);
        tr_job(p.ffn_up + (size_t)1024 * 5632, 1024, 5632, p.ffn_g + 1024, (bf16_t*)(ws + O_WUP + SZ_WUP), 1, tile, gwave, gwaves, wid, lane);
        tr_job(p.ffn_dn, 2816, 1024, nullptr, (bf16_t*)(ws + O_WDN), 0, tile, gwave, gwaves, wid, lane);
        tr_job(p.ffn_dn + (size_t)2816 * 1024, 2816, 1024, nullptr, (bf16_t*)(ws + O_WDN + SZ_WDN), 0, tile, gwave, gwaves, wid, lane);
        tr_job(p.od_w_in, 1024, 3072, p.mix_g + 1024, WODIN, 2, tile, gwave, gwaves, wid, lane);
        tr_job(p.od_w_out, 1024, 1024, nullptr, WODOUT, 0, tile, gwave, gwaves, wid, lane);
        tr_job(p.w_glu, 256, 256, nullptr, WGLU, 0, tile, gwave, gwaves, wid, lane);
        __syncthreads();
        for (int i = gtid; i < 6 * 128 * 128 / 2; i += gthreads) { const int e = i * 2, s = e & 127, t = (e >> 7) & 127;
            const float a = s <= t ? p.gm_ws[e] : 0.f, b = (s + 1) <= t ? p.gm_ws[e + 1] : 0.f; ((unsigned*)WSB)[i] = cvt_pk_bf16(a, b); }
        for (int i = gtid; i < 16 * 64 * 32; i += gthreads) { const int jp = i & 31, pp = (i >> 5) & 63, g = i >> 11;
            float ar, ai, zr, zi; s5_apow(p, g, pp, (float)(31 - jp), ar, ai); s5_z(p, g, pp, zr, zi);
            const float wr_ = ar * zr - ai * zi, wi_ = ar * zi + ai * zr;
            const float* br = p.b_re + (size_t)(g * 64 + pp) * 16; const float* bi = p.b_im + (size_t)(g * 64 + pp) * 16;
            bf16_t* dre = M1T + ((size_t)(g * 256 + pp) * 512 + jp * 16); bf16_t* dim_ = M1T + ((size_t)(g * 256 + 64 + pp) * 512 + jp * 16);
#pragma unroll
            for (int h8 = 0; h8 < 2; ++h8) { u32x4 wre, wim;
                { const float b0r = br[h8 * 8 + 0], b0i = bi[h8 * 8 + 0], b1r = br[h8 * 8 + 1], b1i = bi[h8 * 8 + 1]; wre.x = cvt_pk_bf16(wr_ * b0r - wi_ * b0i, wr_ * b1r - wi_ * b1i); wim.x = cvt_pk_bf16(wr_ * b0i + wi_ * b0r, wr_ * b1i + wi_ * b1r); }
                { const float b0r = br[h8 * 8 + 2], b0i = bi[h8 * 8 + 2], b1r = br[h8 * 8 + 3], b1i = bi[h8 * 8 + 3]; wre.y = cvt_pk_bf16(wr_ * b0r - wi_ * b0i, wr_ * b1r - wi_ * b1i); wim.y = cvt_pk_bf16(wr_ * b0i + wi_ * b0r, wr_ * b1i + wi_ * b1r); }
                { const float b0r = br[h8 * 8 + 4], b0i = bi[h8 * 8 + 4], b1r = br[h8 * 8 + 5], b1i = bi[h8 * 8 + 5]; wre.z = cvt_pk_bf16(wr_ * b0r - wi_ * b0i, wr_ * b1r - wi_ * b1i); wim.z = cvt_pk_bf16(wr_ * b0i + wi_ * b0r, wr_ * b1i + wi_ * b1r); }
                { const float b0r = br[h8 * 8 + 6], b0i = bi[h8 * 8 + 6], b1r = br[h8 * 8 + 7], b1i = bi[h8 * 8 + 7]; wre.w = cvt_pk_bf16(wr_ * b0r - wi_ * b0i, wr_ * b1r - wi_ * b1i); wim.w = cvt_pk_bf16(wr_ * b0i + wi_ * b0r, wr_ * b1i + wi_ * b1r); }
                *(u32x4*)(dre + h8 * 8) = wre; *(u32x4*)(dim_ + h8 * 8) = wim; }
        }
        for (int i = gtid; i < 16 * 128 * 64; i += gthreads) { const int g = i >> 13, r = (i >> 6) & 127, c8 = i & 63;
            *(u32x4*)(M1T + ((size_t)(g * 256 + 128 + r) * 512 + c8 * 8)) = (u32x4){0u, 0u, 0u, 0u}; }
        for (int i = gtid; i < 16 * 32 * 64; i += gthreads) { const int pp = i & 63, j = (i >> 6) & 31, g = i >> 11;
            float ar, ai; s5_apow(p, g, pp, (float)(j + 1), ar, ai);
#pragma unroll 4
            for (int ho = 0; ho < 16; ++ho) { const float cr = p.c_re[(size_t)(g * 16 + ho) * 64 + pp], ci = p.c_im[(size_t)(g * 16 + ho) * 64 + pp];
                bf16_t* d = T2T + ((size_t)(g * 512 + j * 16 + ho) * 640 + 512 + pp);
                d[0] = (bf16_t)(cvt_pk_bf16(cr * ar - ci * ai, 0.f) & 0xffffu); d[64] = (bf16_t)(cvt_pk_bf16(-(cr * ai + ci * ar), 0.f) & 0xffffu); }
        }
        for (int un = gwave; un < 16 * 32; un += gwaves) { const int g = un >> 5, d = un & 31;
            float ar, ai, zr, zi; s5_apow(p, g, lane, (float)d, ar, ai); s5_z(p, g, lane, zr, zi);
            const float wr_ = ar * zr - ai * zi, wi_ = ar * zi + ai * zr;
            const int ho = lane >> 2, hi0 = (lane & 3) * 4;
            f32x4 s = (f32x4){0.f, 0.f, 0.f, 0.f};
#pragma unroll 8
            for (int pp = 0; pp < 64; ++pp) {
                const float zr_p = __int_as_float(__builtin_amdgcn_readlane(__float_as_int(wr_), pp)), zi_p = __int_as_float(__builtin_amdgcn_readlane(__float_as_int(wi_), pp));
                const f32x4 b_r = *(const f32x4*)(p.b_re + (size_t)(g * 64 + pp) * 16 + hi0), b_i = *(const f32x4*)(p.b_im + (size_t)(g * 64 + pp) * 16 + hi0);
                const float cr = p.c_re[(size_t)(g * 16 + ho) * 64 + pp], ci = p.c_im[(size_t)(g * 16 + ho) * 64 + pp];
                const f32x4 tr = zr_p * b_r - zi_p * b_i, ti = zr_p * b_i + zi_p * b_r;
                s += cr * tr - ci * ti; }
            *(f32x4*)(KTAB + (size_t)un * 256 + ho * 16 + hi0) = s; }
        for (int i = gtid; i < 2 * 4 * 2816; i += gthreads) { const int ch = i % 2816, k = (i / 2816) & 3, l = i / (4 * 2816);
            const float* src_ = k < 3 ? p.ffn_cw + (size_t)(l * 3 + k) * 5632 : p.ffn_cb + (size_t)l * 5632;
            ((unsigned*)(ws + O_CWT))[i] = pk_h2(src_[ch] * -1.4426950409f, src_[2816 + ch] * -0.6931471806f); }
        for (int i = gtid; i < 5 * 65536 / 4; i += gthreads) *(f32x4*)(SS + 65536 + (size_t)i * 4) = (f32x4){0.f, 0.f, 0.f, 0.f};
        for (int row = gwave; row < MTOK; row += 2 * gwaves) {
            f32x4 xv[2][4];
#pragma unroll
            for (int q = 0; q < 2; ++q) { const int r = row + q * gwaves; const float* xr = p.x + (size_t)(r < MTOK ? r : row) * 1024;
                xv[q][0] = *(const f32x4*)(xr + lane * 8); xv[q][1] = *(const f32x4*)(xr + lane * 8 + 4); xv[q][2] = *(const f32x4*)(xr + 512 + lane * 8); xv[q][3] = *(const f32x4*)(xr + 512 + lane * 8 + 4); }
#pragma unroll
            for (int q = 0; q < 2; ++q) { const int r = row + q * gwaves; if (r >= MTOK) continue;
                *(u32x4*)(HB + (size_t)r * 1024 + lane * 8) = pack8(xv[q][0], xv[q][1]); *(u32x4*)(HB + (size_t)r * 1024 + 512 + lane * 8) = pack8(xv[q][2], xv[q][3]);
                float s = dot4(xv[q][0]) + dot4(xv[q][1]) + dot4(xv[q][2]) + dot4(xv[q][3]);
                s += __shfl_xor(s, 32); s += __shfl_xor(s, 16); s += __shfl_xor(s, 8); s += __shfl_xor(s, 4); s += __shfl_xor(s, 2); s += __shfl_xor(s, 1);
                if (lane == 0) ss0[r] = s; } }
    }
    grid.sync();
    { PHASE_PTRS PHASE_IDS
    for (int i = gtid; i < 16 * 512 * 32; i += gthreads) { const int jp = i & 31, nrow = (i >> 5) & 511, g = i >> 14, j = nrow >> 4, ho = nrow & 15;
        u32x4 w0 = (u32x4){0u, 0u, 0u, 0u}, w1 = w0;
        if (jp <= j) { const float* k = KTAB + ((size_t)(g * 32 + (j - jp)) * 256 + ho * 16);
            const f32x4 k0 = *(const f32x4*)k, k1 = *(const f32x4*)(k + 4), k2 = *(const f32x4*)(k + 8), k3 = *(const f32x4*)(k + 12); w0 = pack8(k0, k1); w1 = pack8(k2, k3); }
        bf16_t* d = T2T + ((size_t)(g * 512 + nrow) * 640 + jp * 16); *(u32x4*)d = w0; *(u32x4*)(d + 8) = w1; } }

    layer_body<0>(lds, nbar);
    layer_body<1>(lds, nbar);
    { PHASE_PTRS PHASE_IDS
    for (int row = gwave; row < MTOK; row += 4 * gwaves) {
        u32x4 hv[4][2]; float sv[4];
#pragma unroll
        for (int q = 0; q < 4; ++q) { const int r = row + q * gwaves; sv[q] = 1.0f; hv[q][0] = hv[q][1] = (u32x4){0u, 0u, 0u, 0u};
            if (r < MTOK) { const bf16_t* hr = HB + (size_t)r * 1024; hv[q][0] = *(const u32x4*)(hr + lane * 8); hv[q][1] = *(const u32x4*)(hr + 512 + lane * 8); sv[q] = ssfin[r]; } }
        const f32x4 g0 = *(const f32x4*)(p.fin_g + lane * 8), g1 = *(const f32x4*)(p.fin_g + lane * 8 + 4), g2 = *(const f32x4*)(p.fin_g + 512 + lane * 8), g3 = *(const f32x4*)(p.fin_g + 512 + lane * 8 + 4);
#pragma unroll
        for (int q = 0; q < 4; ++q) { const int r = row + q * gwaves; if (r >= MTOK) continue; float* orow = p.out + (size_t)r * 1024; const float rs = rnorm(sv[q]);
            f32x4 a, b; unpack8(hv[q][0], a, b); *(f32x4*)(orow + lane * 8) = a * rs * g0; *(f32x4*)(orow + lane * 8 + 4) = b * rs * g1;
            unpack8(hv[q][1], a, b); *(f32x4*)(orow + 512 + lane * 8) = a * rs * g2; *(f32x4*)(orow + 512 + lane * 8 + 4) = b * rs * g3; }
    } }
}

extern "C" void kernel_launch(void* const* d_in, const int* in_sizes, int n_in, void* d_out, int out_size, void* d_ws, size_t ws_size, hipStream_t stream) {
    static int grid_blocks = 0;
    if (!grid_blocks) {
        if (ws_size < WS_NEED) { fprintf(stderr, "kernel_launch: workspace too small: %zu < %zu\n", ws_size, (size_t)WS_NEED); grid_blocks = -1; return; }
        int dev = 0, cus = 0, per_cu = 0;
        (void)hipGetDevice(&dev); (void)hipDeviceGetAttribute(&cus, hipDeviceAttributeMultiprocessorCount, dev);
        if (hipFuncSetAttribute((const void*)fwd_kernel, hipFuncAttributeMaxDynamicSharedMemorySize, LDS_BYTES) != hipSuccess) fprintf(stderr, "kernel_launch: hipFuncSetAttribute failed\n");
        if (hipOccupancyMaxActiveBlocksPerMultiprocessor(&per_cu, (const void*)fwd_kernel, 512, LDS_BYTES) != hipSuccess || per_cu < 1) { fprintf(stderr, "kernel_launch: occupancy query says %d\n", per_cu); per_cu = 1; }
        (void)hipGetLastError();
        grid_blocks = cus;
    }
    if (grid_blocks < 0) return;
    Params p{};
    const float** fp = (const float**)&p;
    for (int i = 0; i < 27; ++i) fp[i] = (const float*)d_in[i];
    p.out = (float*)d_out; p.ws = (unsigned char*)d_ws;
    if (hipMemsetAsync((char*)d_ws + O_BAR, 0, 16384, stream) != hipSuccess) fprintf(stderr, "kernel_launch: memset failed\n");
    void* args[] = {&p};
    hipError_t e = hipLaunchCooperativeKernel((const void*)fwd_kernel, dim3(grid_blocks), dim3(512), args, LDS_BYTES, stream);
    if (e != hipSuccess) fprintf(stderr, "cooperative launch failed: %s (grid %d)\n", hipGetErrorString(e), grid_blocks);
}
```

```cpp
#include <hip/hip_runtime.h>
#include <hip/hip_cooperative_groups.h>
#include <cstdio>
namespace cg = cooperative_groups;

#define LAS __attribute__((address_space(3)))
typedef unsigned short bf16_t;
typedef short bf16x8 __attribute__((ext_vector_type(8)));
typedef float f32x4 __attribute__((ext_vector_type(4)));
typedef unsigned u32x4 __attribute__((ext_vector_type(4)));
typedef unsigned u32x2 __attribute__((ext_vector_type(2)));

constexpr int MTOK = 65536;
constexpr float EPS = 1e-6f;
constexpr int BM = 256, BK = 64, HALF = 128, HTB = HALF * BK * 2, STAGE_BYTES = 8 * HTB, LDS_BYTES = STAGE_BYTES + 64, NXCD = 8, WGM = 8;

constexpr size_t O_WIN0 = 0;
constexpr size_t O_WOUT0 = O_WIN0 + (size_t)1792 * 1024 * 2;
constexpr size_t O_WUP = O_WOUT0 + (size_t)1024 * 1024 * 2;
constexpr size_t SZ_WUP = (size_t)5632 * 1024 * 2;
constexpr size_t O_WDN = O_WUP + 2 * SZ_WUP;
constexpr size_t SZ_WDN = (size_t)1024 * 2816 * 2;
constexpr size_t O_WODIN = O_WDN + 2 * SZ_WDN;
constexpr size_t O_WODOUT = O_WODIN + (size_t)3072 * 1024 * 2;
constexpr size_t O_WGLU = O_WODOUT + (size_t)1024 * 1024 * 2;
constexpr size_t O_M1T = O_WGLU + (size_t)256 * 256 * 2;
constexpr size_t O_T2T = O_M1T + (size_t)16 * 256 * 1024 * 2;
constexpr size_t O_WSB = O_T2T + (size_t)16 * 1024 * 1152 * 2;
constexpr size_t O_KTAB = O_WSB + (size_t)6 * 128 * 128 * 2;
constexpr size_t O_SS = O_KTAB + (size_t)16 * 64 * 256 * 4;
constexpr size_t O_BAR = O_SS + (size_t)6 * 65536 * 4;
constexpr size_t O_CWT = O_BAR + 16384;
constexpr size_t O_HB = O_CWT + (size_t)2 * 4 * 2816 * 4;
constexpr size_t O_R = O_HB + (size_t)MTOK * 1024 * 2;
constexpr size_t O_UH = O_R;
constexpr size_t O_S = O_UH + (size_t)16 * 2048 * 640 * 2;
constexpr size_t O_U = O_S + (size_t)32768 * 128 * 4;
constexpr size_t O_V = O_U + (size_t)MTOK * 768 * 2;
constexpr size_t O_Y1 = O_V + (size_t)MTOK * 768 * 2;
constexpr size_t O_MIX = O_Y1 + (size_t)MTOK * 256 * 2;
constexpr size_t O_END0 = O_MIX + (size_t)MTOK * 1024 * 2;
constexpr size_t O_BG = O_R;
constexpr size_t O_Z = O_BG + (size_t)MTOK * 1024 * 2;
static_assert(O_Z + (size_t)MTOK * 1024 * 2 <= O_MIX, "layer-1 mixer buffers overlap MIX");
constexpr size_t O_G = O_R;
constexpr size_t O_UB = O_G + (size_t)MTOK * 2816 * 2;
constexpr size_t O_END1 = O_UB + (size_t)1024 * 4 * 5632 * 2;
constexpr size_t WS_NEED = O_END0 > O_END1 ? O_END0 : O_END1;

struct Params {
    const float *x, *mix_g, *ffn_g, *fin_g, *ev_w_in, *ev_w_out, *lam_re, *lam_im, *log_dt, *b_re, *b_im, *c_re, *c_im, *s5_d, *w_glu, *b_glu,
        *gm_ws, *gm_bs, *gm_vg, *od_w_in, *od_cw, *od_cb, *od_w_out, *ffn_up, *ffn_cw, *ffn_cb, *ffn_dn;
    float* out; unsigned char* ws;
};

__device__ __forceinline__ unsigned cvt_pk_bf16(float lo, float hi) { unsigned r; asm("v_cvt_pk_bf16_f32 %0, %1, %2" : "=v"(r) : "v"(lo), "v"(hi)); return r; }
__device__ __forceinline__ u32x4 pack8(f32x4 a, f32x4 b) { u32x4 w; w.x = cvt_pk_bf16(a[0], a[1]); w.y = cvt_pk_bf16(a[2], a[3]); w.z = cvt_pk_bf16(b[0], b[1]); w.w = cvt_pk_bf16(b[2], b[3]); return w; }
__device__ __forceinline__ float bflo(unsigned w) { return __uint_as_float(w << 16); }
__device__ __forceinline__ float bfhi(unsigned w) { return __uint_as_float(w & 0xffff0000u); }
__device__ __forceinline__ void unpack8(u32x4 w, f32x4& a, f32x4& b) { a = (f32x4){bflo(w.x), bfhi(w.x), bflo(w.y), bfhi(w.y)}; b = (f32x4){bflo(w.z), bfhi(w.z), bflo(w.w), bfhi(w.w)}; }
__device__ __forceinline__ float gelu_t(float x) { const float u = x * (0.7978845608f + 0.0356774081f * x * x); return x * __builtin_amdgcn_rcpf(1.0f + __builtin_amdgcn_exp2f(-2.885390082f * u)); }
__device__ __forceinline__ float sigm(float x) { return __builtin_amdgcn_rcpf(1.0f + __builtin_amdgcn_exp2f(-1.442695041f * x)); }
__device__ __forceinline__ f32x4 gelu4(f32x4 v) { return (f32x4){gelu_t(v[0]), gelu_t(v[1]), gelu_t(v[2]), gelu_t(v[3])}; }
__device__ __forceinline__ float ror1(float v) { return __int_as_float(__builtin_amdgcn_update_dpp(0, __float_as_int(v), 0x121, 0xf, 0xf, false)); }
__device__ __forceinline__ float ror2(float v) { return __int_as_float(__builtin_amdgcn_update_dpp(0, __float_as_int(v), 0x122, 0xf, 0xf, false)); }
typedef _Float16 h2_t __attribute__((ext_vector_type(2)));
__device__ __forceinline__ unsigned pk_h2(float a, float b) { return __builtin_bit_cast(unsigned, __builtin_amdgcn_cvt_pkrtz(a, b)); }
__device__ __forceinline__ h2_t as_h2(unsigned v) { return __builtin_bit_cast(h2_t, v); }
__device__ __forceinline__ unsigned ror1u(unsigned v) { return (unsigned)__builtin_amdgcn_update_dpp(0, (int)v, 0x121, 0xf, 0xf, true); }
__device__ __forceinline__ unsigned ror2u(unsigned v) { return (unsigned)__builtin_amdgcn_update_dpp(0, (int)v, 0x122, 0xf, 0xf, true); }
__device__ __forceinline__ float rnorm(float ss) { return rsqrtf(ss * (1.0f / 1024.0f) + EPS); }
__device__ __forceinline__ float dot4(f32x4 a) { return (a[0] * a[0] + a[1] * a[1]) + (a[2] * a[2] + a[3] * a[3]); }

__host__ __device__ __forceinline__ int lds_byte(int r, int c) { const int st = (r >> 4) * 2 + (c >> 5), rr = r & 15, cc = c & 31, ob = rr * 64 + cc * 2; return st * 1024 + (ob ^ (((ob >> 9) & 1) << 5)); }
__host__ __device__ __forceinline__ void stage_rc(int b, int& R, int& C) { const int st = b / 1024, sb = b % 1024, swz = sb ^ (((sb >> 9) & 1) << 5); R = (st >> 1) * 16 + swz / 64; C = (st & 1) * 32 + (swz % 64) / 2; }
__host__ __device__ __forceinline__ int perm32(int rho) { const int n = rho >> 4, i = rho & 15; return 8 * (i >> 2) + 4 * n + (i & 3); }

struct Unit { int pm, pn; };
struct Gemm { const bf16_t* A; const bf16_t* Bt; int M, N, K, lda; int bgt; size_t bgs; };
struct StaticOrder {
    int nM, nN, nwg, G, c;
    __device__ void init(int M, int N, int G_, int c_) { nM = M / BM; nN = N / BM; nwg = nM * nN; G = G_; c = c_; }
    __device__ bool next(int i, Unit& u) const {
        const long L = (long)i * G + c; if (L >= nwg) return false;
        int wgid = (int)L; { const int q = nwg / NXCD, r = nwg % NXCD, xcd = wgid % NXCD, off = wgid / NXCD; wgid = (xcd < r ? xcd * (q + 1) : r * (q + 1) + (xcd - r) * q) + off; }
        const int nig = WGM * nN, gid = wgid / nig, fm = gid * WGM, gsz = (nM - fm) < WGM ? (nM - fm) : WGM;
        u.pm = fm + ((wgid % nig) % gsz); u.pn = (wgid % nig) / gsz; return true;
    }
};

template <class Epi>
__device__ __forceinline__ void gemm_phase(LAS unsigned char* lds, const Gemm g, const StaticOrder& S, const Epi& E) {
    int tid = threadIdx.x; asm volatile("" : "+v"(tid)); const int wid = __builtin_amdgcn_readfirstlane(tid >> 6), lane = tid & 63, wr = wid >> 2, wc = wid & 3, fr = lane & 15, fq = lane >> 4;
    const int K = g.K, nt = K / BK, lda = g.lda;
    unsigned voffA[2], voffB[2];
#pragma unroll
    for (int i = 0; i < 2; ++i) { int R, C; stage_rc(tid * 16 + i * 8192, R, C); const int Rb = (R & ~31) + perm32(R & 31);
        voffA[i] = (unsigned)(R * lda + C) * 2u; voffB[i] = (unsigned)(Rb * K + C) * 2u; }
    const size_t kstep = (size_t)(BK * 2);
    const size_t hstepA = (size_t)HALF * lda * 2, hstepB = (size_t)HALF * K * 2;
    const size_t tstepA = 2 * hstepA, tstepB = 2 * hstepB;
    const unsigned ldsw = (unsigned)wid * 1024u;
    const int aoff = lds_byte(wr * 64 + fr, fq * 8), boff = lds_byte(wc * 32 + fr, fq * 8);
#define PG8_SA(b, h) (((b) * 2 + (h)) * HTB)
#define PG8_SB(b, h) ((4 + (b) * 2 + (h)) * HTB)
#define PG8_STAGE(bufoff, gbase, voff) do { _Pragma("unroll") for (int _i = 0; _i < 2; ++_i) \
        __builtin_amdgcn_global_load_lds((const unsigned*)((const char*)(gbase) + (voff)[_i]), (LAS unsigned*)(lds + (bufoff) + ldsw + _i * 8192), 16, 0, 0); } while (0)
#define PG8_LDA(dst, b, h) do { _Pragma("unroll") for (int m = 0; m < 4; ++m) _Pragma("unroll") for (int k = 0; k < 2; ++k) dst[m][k] = *(const LAS bf16x8*)(lds + PG8_SA(b, h) + aoff + m * 2048 + k * 1024); } while (0)
#define PG8_LDB(dst, b, h) do { _Pragma("unroll") for (int n = 0; n < 2; ++n) _Pragma("unroll") for (int k = 0; k < 2; ++k) dst[n][k] = *(const LAS bf16x8*)(lds + PG8_SB(b, h) + boff + n * 2048 + k * 1024); } while (0)
#define PG8_MMA(ai, bj, At, Bt) do { __builtin_amdgcn_s_setprio(1); _Pragma("unroll") for (int m = 0; m < 4; ++m) _Pragma("unroll") for (int n = 0; n < 2; ++n) _Pragma("unroll") for (int k = 0; k < 2; ++k) \
        acc[ai][bj][m][n] = __builtin_amdgcn_mfma_f32_16x16x32_bf16(Bt[n][k], At[m][k], acc[ai][bj][m][n], 0, 0, 0); __builtin_amdgcn_s_setprio(0); } while (0)
#define PG8_WAIT_V(n) asm volatile("s_waitcnt vmcnt(" #n ")" ::: "memory")
#define PG8_WAIT_L(n) asm volatile("s_waitcnt lgkmcnt(" #n ")" ::: "memory")
#define PG8_BAR __builtin_amdgcn_s_barrier()
#define PG8_SCHED __builtin_amdgcn_sched_barrier(0)
    Unit cur, nxt; int ui = 0;
    if (!S.next(0, cur)) return;
    f32x4 acc[2][2][4][2];
#pragma unroll
    for (int a = 0; a < 2; ++a)
#pragma unroll
        for (int b = 0; b < 2; ++b)
#pragma unroll
            for (int m = 0; m < 4; ++m)
#pragma unroll
                for (int n = 0; n < 2; ++n) acc[a][b][m][n] = (f32x4){0.f, 0.f, 0.f, 0.f};
    bf16x8 At[4][2], B0[2][2], B1[2][2];
    const char* cA = (const char*)g.A + (size_t)cur.pm * tstepA;
    const char* cB = (const char*)g.Bt + (size_t)cur.pn * tstepB + (g.bgt ? (size_t)(cur.pm / g.bgt) * g.bgs : (size_t)0);
    PG8_STAGE(PG8_SB(0, 0), cB, voffB); PG8_STAGE(PG8_SA(0, 0), cA, voffA); PG8_STAGE(PG8_SB(0, 1), cB + hstepB, voffB); PG8_STAGE(PG8_SA(0, 1), cA + hstepA, voffA);
    if (wr == 1) PG8_BAR;
    PG8_WAIT_V(4); PG8_BAR;
    PG8_STAGE(PG8_SB(1, 0), cB + kstep, voffB); PG8_STAGE(PG8_SA(1, 0), cA + kstep, voffA); PG8_STAGE(PG8_SB(1, 1), cB + hstepB + kstep, voffB);
    PG8_WAIT_V(6); PG8_BAR;
    for (;;) {
        const bool has_next = S.next(ui + 1, nxt);
        const char* nA = has_next ? (const char*)g.A + (size_t)nxt.pm * tstepA : cA;
        const char* nB = has_next ? (const char*)g.Bt + (size_t)nxt.pn * tstepB + (g.bgt ? (size_t)(nxt.pm / g.bgt) * g.bgs : (size_t)0) : cB;
        for (int t = 0; t < nt; t += 2) {
            const bool last = (t == nt - 2);
            const char* a1 = cA + (size_t)(t + 1) * kstep;
            const char* a2 = last ? nA : cA + (size_t)(t + 2) * kstep; const char* b2 = last ? nB : cB + (size_t)(t + 2) * kstep;
            const char* a3 = a2 + kstep; const char* b3 = b2 + kstep;
            PG8_LDB(B0, 0, 0); PG8_SCHED; PG8_LDA(At, 0, 0); PG8_STAGE(PG8_SA(1, 1), a1 + hstepA, voffA);
            PG8_WAIT_L(8); PG8_BAR; PG8_WAIT_L(0); PG8_MMA(0, 0, At, B0); PG8_BAR; PG8_SCHED;
            PG8_LDB(B1, 0, 1); PG8_STAGE(PG8_SB(0, 0), b2, voffB);
            PG8_BAR; PG8_WAIT_L(0); PG8_MMA(0, 1, At, B1); PG8_BAR;
            PG8_LDA(At, 0, 1); PG8_STAGE(PG8_SA(0, 0), a2, voffA);
            PG8_BAR; PG8_WAIT_L(0); PG8_MMA(1, 0, At, B0); PG8_BAR; PG8_SCHED;
            PG8_STAGE(PG8_SB(0, 1), b2 + hstepB, voffB);
            PG8_WAIT_V(6); PG8_BAR; PG8_MMA(1, 1, At, B1); PG8_BAR;
            PG8_LDB(B0, 1, 0); PG8_SCHED; PG8_LDA(At, 1, 0); PG8_STAGE(PG8_SA(0, 1), a2 + hstepA, voffA);
            PG8_WAIT_L(8); PG8_BAR; PG8_WAIT_L(0); PG8_MMA(0, 0, At, B0); PG8_BAR; PG8_SCHED;
            PG8_LDB(B1, 1, 1); PG8_STAGE(PG8_SB(1, 0), b3, voffB);
            PG8_BAR; PG8_WAIT_L(0); PG8_MMA(0, 1, At, B1); PG8_BAR;
            PG8_LDA(At, 1, 1); PG8_STAGE(PG8_SA(1, 0), a3, voffA);
            PG8_BAR; PG8_WAIT_L(0); PG8_MMA(1, 0, At, B0); PG8_BAR; PG8_SCHED;
            PG8_STAGE(PG8_SB(1, 1), b3 + hstepB, voffB);
            PG8_WAIT_V(6); PG8_BAR; PG8_MMA(1, 1, At, B1); PG8_BAR;
        }
        { int t2 = threadIdx.x; asm volatile("" : "+v"(t2)); E(acc, cur, wr, wc, t2 & 15, (t2 & 63) >> 4); }
        if (!has_next) break;
#pragma unroll
        for (int a = 0; a < 2; ++a)
#pragma unroll
            for (int b = 0; b < 2; ++b)
#pragma unroll
                for (int m = 0; m < 4; ++m)
#pragma unroll
                    for (int n = 0; n < 2; ++n) acc[a][b][m][n] = (f32x4){0.f, 0.f, 0.f, 0.f};
        cur = nxt; cA = nA; cB = nB; ++ui;
    }
    PG8_WAIT_V(0);
    if (wr == 0) PG8_BAR;
    PG8_BAR;
#undef PG8_SA
#undef PG8_SB
#undef PG8_STAGE
#undef PG8_LDA
#undef PG8_LDB
#undef PG8_MMA
#undef PG8_WAIT_V
#undef PG8_WAIT_L
#undef PG8_BAR
#undef PG8_SCHED
}

typedef f32x4 Acc[2][2][4][2];

struct EpiIn0 {
    const float* ss; bf16_t* UH; bf16_t* U; bf16_t* V; float* vss;
    __device__ __forceinline__ void operator()(Acc& acc, const Unit& u, int wr, int wc, int fr, int fq) const {
        const int row0 = u.pm * BM + wr * 64 + fr, cin = wc * 32 + 8 * fq;
        float rsv[2][4];
#pragma unroll
        for (int ai = 0; ai < 2; ++ai)
#pragma unroll
            for (int m = 0; m < 4; ++m) rsv[ai][m] = ss[row0 + ai * HALF + m * 16];
        __builtin_amdgcn_sched_barrier(0);
#pragma unroll
        for (int ai = 0; ai < 2; ++ai)
#pragma unroll
            for (int m = 0; m < 4; ++m) {
                const int row = row0 + ai * HALF + m * 16; const float rs = rnorm(rsv[ai][m]);
                if (u.pn == 0) {
#pragma unroll
                    for (int bj = 0; bj < 2; ++bj) { const int col = bj * HALF + cin, g = col >> 4, ch0 = col & 15;
                        *(u32x4*)(UH + ((size_t)(g * 2048 + (row >> 5)) * 640 + (row & 31) * 16 + ch0)) = pack8(acc[ai][bj][m][0] * rs, acc[ai][bj][m][1] * rs); }
                } else if (u.pn < 4) {
#pragma unroll
                    for (int bj = 0; bj < 2; ++bj) { const int col = (u.pn - 1) * BM + bj * HALF + cin;
                        *(u32x4*)(U + (size_t)row * 768 + col) = pack8(gelu4(acc[ai][bj][m][0] * rs), gelu4(acc[ai][bj][m][1] * rs)); }
                } else {
                    float sq = 0.f;
#pragma unroll
                    for (int bj = 0; bj < 2; ++bj) { const int col = (u.pn - 4) * BM + bj * HALF + cin;
                        const f32x4 a = gelu4(acc[ai][bj][m][0] * rs), b = gelu4(acc[ai][bj][m][1] * rs); sq += dot4(a) + dot4(b);
                        *(u32x4*)(V + (size_t)row * 768 + col) = pack8(a, b); }
                    sq += __shfl_xor(sq, 16); sq += __shfl_xor(sq, 32);
                    if (fq == 0) unsafeAtomicAdd(vss + row, sq);
                }
            }
    }
};
struct EpiS5a {
    float* S;
    __device__ __forceinline__ void operator()(Acc& acc, const Unit& u, int wr, int wc, int fr, int fq) const {
        const int row0 = u.pm * BM + wr * 64 + fr, cin = wc * 32 + 8 * fq;
#pragma unroll
        for (int ai = 0; ai < 2; ++ai)
#pragma unroll
            for (int m = 0; m < 4; ++m) { float* dst = S + (size_t)(row0 + ai * HALF + m * 16) * 128 + cin;
                *(f32x4*)dst = acc[ai][0][m][0]; *(f32x4*)(dst + 4) = acc[ai][0][m][1]; }
    }
};
struct EpiS5b {
    const bf16_t* UH; const float* dsk; bf16_t* Y1;
    __device__ __forceinline__ void operator()(Acc& acc, const Unit& u, int wr, int wc, int fr, int fq) const {
        const int row0 = u.pm * BM + wr * 64 + fr, cin = wc * 32 + 8 * fq;
        u32x4 uw[2][4][2]; f32x4 dv[2][2];
#pragma unroll
        for (int bj = 0; bj < 2; ++bj) { const int col = u.pn * BM + bj * HALF + cin, ch0 = col & 15, g = row0 >> 11;
            dv[bj][0] = *(const f32x4*)(dsk + g * 16 + ch0); dv[bj][1] = *(const f32x4*)(dsk + g * 16 + ch0 + 4);
#pragma unroll
            for (int ai = 0; ai < 2; ++ai)
#pragma unroll
                for (int m = 0; m < 4; ++m) uw[ai][m][bj] = *(const u32x4*)(UH + (size_t)(row0 + ai * HALF + m * 16) * 640 + col); }
        __builtin_amdgcn_sched_barrier(0);
#pragma unroll
        for (int ai = 0; ai < 2; ++ai)
#pragma unroll
            for (int m = 0; m < 4; ++m) {
                const int grow = row0 + ai * HALF + m * 16, g = grow >> 11, bc = grow & 2047;
#pragma unroll
                for (int bj = 0; bj < 2; ++bj) { const int col = u.pn * BM + bj * HALF + cin, jj = col >> 4, ch0 = col & 15;
                    f32x4 u0, u1; unpack8(uw[ai][m][bj], u0, u1);
                    const size_t tok = (size_t)(bc >> 7) * 4096 + (bc & 127) * 32 + jj;
                    *(u32x4*)(Y1 + tok * 256 + g * 16 + ch0) = pack8(gelu4(acc[ai][bj][m][0] + dv[bj][0] * u0), gelu4(acc[ai][bj][m][1] + dv[bj][1] * u1)); }
            }
    }
};
struct EpiGlu {
    const bf16_t* Y1; const float* bglu; bf16_t* MIX;
    __device__ __forceinline__ void operator()(Acc& acc, const Unit& u, int wr, int wc, int fr, int fq) const {
        const int row0 = u.pm * BM + wr * 64 + fr, cin = wc * 32 + 8 * fq;
        u32x4 yv[2][4][2]; f32x4 bv[2][2];
#pragma unroll
        for (int bj = 0; bj < 2; ++bj) { const int col = bj * HALF + cin; bv[bj][0] = *(const f32x4*)(bglu + col); bv[bj][1] = *(const f32x4*)(bglu + col + 4);
#pragma unroll
            for (int ai = 0; ai < 2; ++ai)
#pragma unroll
                for (int m = 0; m < 4; ++m) yv[ai][m][bj] = *(const u32x4*)(Y1 + (size_t)(row0 + ai * HALF + m * 16) * 256 + col); }
        __builtin_amdgcn_sched_barrier(0);
#pragma unroll
        for (int ai = 0; ai < 2; ++ai)
#pragma unroll
            for (int m = 0; m < 4; ++m) { const int row = row0 + ai * HALF + m * 16;
#pragma unroll
                for (int bj = 0; bj < 2; ++bj) { const int col = bj * HALF + cin;
                    f32x4 y0, y1; unpack8(yv[ai][m][bj], y0, y1);
                    const f32x4 z0 = acc[ai][bj][m][0] + bv[bj][0], z1 = acc[ai][bj][m][1] + bv[bj][1];
                    const f32x4 o0 = (f32x4){y0[0] * sigm(z0[0]), y0[1] * sigm(z0[1]), y0[2] * sigm(z0[2]), y0[3] * sigm(z0[3])};
                    const f32x4 o1 = (f32x4){y1[0] * sigm(z1[0]), y1[1] * sigm(z1[1]), y1[2] * sigm(z1[2]), y1[3] * sigm(z1[3])};
                    *(u32x4*)(MIX + (size_t)row * 1024 + col) = pack8(o0, o1); }
            }
    }
};
struct EpiRes {
    bf16_t* hb; float* ss;
    __device__ __forceinline__ void operator()(Acc& acc, const Unit& u, int wr, int wc, int fr, int fq) const {
        const int row0 = u.pm * BM + wr * 64 + fr, cin = u.pn * BM + wc * 32 + 8 * fq;
        bf16_t* hbp = hb + (size_t)row0 * 1024 + cin;
        u32x4 hv[2][4][2];
#pragma unroll
        for (int ai = 0; ai < 2; ++ai)
#pragma unroll
            for (int m = 0; m < 4; ++m)
#pragma unroll
                for (int bj = 0; bj < 2; ++bj) hv[ai][m][bj] = *(const u32x4*)(hbp + (size_t)(ai * HALF + m * 16) * 1024 + bj * HALF);
        __builtin_amdgcn_sched_barrier(0);
#pragma unroll
        for (int ai = 0; ai < 2; ++ai)
#pragma unroll
            for (int m = 0; m < 4; ++m) { const int row = row0 + ai * HALF + m * 16; float sq = 0.f;
#pragma unroll
                for (int bj = 0; bj < 2; ++bj) {
                    f32x4 a, b; unpack8(hv[ai][m][bj], a, b); a += acc[ai][bj][m][0]; b += acc[ai][bj][m][1];
                    *(u32x4*)(hbp + (size_t)(ai * HALF + m * 16) * 1024 + bj * HALF) = pack8(a, b); sq += dot4(a) + dot4(b); }
                sq += __shfl_xor(sq, 16); sq += __shfl_xor(sq, 32);
                if (fq == 0) unsafeAtomicAdd(ss + row, sq);
            }
    }
};
struct EpiFfnUp {
    const float* ss; const unsigned* cwt; bf16_t* G; unsigned* Ub;
    __device__ __forceinline__ void operator()(Acc& acc, const Unit& u, int wr, int wc, int fr, int fq) const {
        const int row0 = u.pm * BM + wr * 64 + fr;
        const float* ssr = ss + row0;
        const int ch0 = u.pn * HALF + wc * 32 + 8 * fq;
        const unsigned* cp = cwt + ch0;
        u32x4 pw[4][2];
#pragma unroll
        for (int k = 0; k < 4; ++k) { pw[k][0] = *(const u32x4*)(cp + k * 2816); pw[k][1] = *(const u32x4*)(cp + k * 2816 + 4); }
        unsigned gv[2][4][2][4];
#pragma unroll
        for (int ai = 0; ai < 2; ++ai)
#pragma unroll
            for (int m = 0; m < 4; ++m) { const float rs = rnorm(ssr[ai * HALF + m * 16]);
#pragma unroll
                for (int n = 0; n < 2; ++n) { const f32x4 gsv = acc[ai][0][m][n] * rs, vsv = acc[ai][1][m][n] * rs;
#pragma unroll
                    for (int j = 0; j < 4; ++j) gv[ai][m][n][j] = pk_h2(gsv[j], vsv[j]); } }
#pragma unroll
        for (int ai = 0; ai < 2; ++ai) { const int strip = u.pm * 4 + ai * 2 + wr;
            if (fr < 2) { unsigned* d = Ub + (size_t)(strip * 4 + fr) * 2816 + ch0;
                *(u32x4*)d = (u32x4){gv[ai][0][0][0], gv[ai][0][0][1], gv[ai][0][0][2], gv[ai][0][0][3]}; *(u32x4*)(d + 4) = (u32x4){gv[ai][0][1][0], gv[ai][0][1][1], gv[ai][0][1][2], gv[ai][0][1][3]}; }
            if (fr >= 14) { unsigned* d = Ub + (size_t)(strip * 4 + fr - 12) * 2816 + ch0;
                *(u32x4*)d = (u32x4){gv[ai][3][0][0], gv[ai][3][0][1], gv[ai][3][0][2], gv[ai][3][0][3]}; *(u32x4*)(d + 4) = (u32x4){gv[ai][3][1][0], gv[ai][3][1][1], gv[ai][3][1][2], gv[ai][3][1][3]}; }
        }
        const bool f1 = fr >= 1, f2 = fr >= 2;
        bf16_t* gp_ = G + (size_t)row0 * 2816 + ch0;
#pragma unroll
        for (int ai = 0; ai < 2; ++ai) {
            unsigned p1[2][4], p2[2][4];
#pragma unroll
            for (int n = 0; n < 2; ++n)
#pragma unroll
                for (int j = 0; j < 4; ++j) { p1[n][j] = 0u; p2[n][j] = 0u; }
#pragma unroll
            for (int m = 0; m < 4; ++m) {
                f32x4 o[2];
#pragma unroll
                for (int n = 0; n < 2; ++n)
#pragma unroll
                    for (int j = 0; j < 4; ++j) {
                        const unsigned cur = gv[ai][m][n][j];
                        const unsigned r1 = ror1u(cur), r2 = ror2u(cur);
                        const unsigned t1 = f1 ? r1 : p1[n][j], t2 = f2 ? r2 : p2[n][j];
                        p1[n][j] = r1; p2[n][j] = r2;
                        h2_t c = as_h2(pw[2][n][j]) * as_h2(cur) + as_h2(pw[3][n][j]);
                        c = as_h2(pw[1][n][j]) * as_h2(t1) + c;
                        c = as_h2(pw[0][n][j]) * as_h2(t2) + c;
                        const float lo = (float)c.x, hi = (float)c.y;
                        o[n][j] = lo * hi * __builtin_amdgcn_rcpf(1.0f + __builtin_amdgcn_exp2f(lo));
                    }
                *(u32x4*)(gp_ + (size_t)(ai * HALF + m * 16) * 2816) = pack8(o[0], o[1]);
            }
        }
    }
};
struct EpiOdIn {
    const float* ss; bf16_t* BG; bf16_t* Z;
    __device__ __forceinline__ void operator()(Acc& acc, const Unit& u, int wr, int wc, int fr, int fq) const {
        const int row0 = u.pm * BM + wr * 64 + fr, cin = wc * 32 + 8 * fq;
        float rsv[2][4];
#pragma unroll
        for (int ai = 0; ai < 2; ++ai)
#pragma unroll
            for (int m = 0; m < 4; ++m) rsv[ai][m] = ss[row0 + ai * HALF + m * 16];
        __builtin_amdgcn_sched_barrier(0);
#pragma unroll
        for (int ai = 0; ai < 2; ++ai)
#pragma unroll
            for (int m = 0; m < 4; ++m) { const int row = row0 + ai * HALF + m * 16; const float rs = rnorm(rsv[ai][m]);
                if (u.pn < 4) {
#pragma unroll
                    for (int bj = 0; bj < 2; ++bj) *(u32x4*)(BG + (size_t)row * 1024 + u.pn * BM + bj * HALF + cin) = pack8(acc[ai][bj][m][0] * rs, acc[ai][bj][m][1] * rs);
                } else { const float r2 = rs * rs;
                    *(u32x4*)(Z + (size_t)row * 1024 + (u.pn - 4) * HALF + cin) = pack8(acc[ai][0][m][0] * acc[ai][1][m][0] * r2, acc[ai][0][m][1] * acc[ai][1][m][1] * r2); }
            }
    }
};

template <class Epi> __device__ __forceinline__ void run_gemm(LAS unsigned char* lds, const bf16_t* A, const bf16_t* Bt, int M, int N, int K, int lda, int bgt, size_t bgs, const Epi& E) {
    Gemm g; g.A = A; g.Bt = Bt; g.M = M; g.N = N; g.K = K; g.lda = lda; g.bgt = bgt; g.bgs = bgs;
    int c_ = (int)blockIdx.x, G_ = (int)gridDim.x; asm volatile("" : "+s"(c_), "+s"(G_));
    StaticOrder S; S.init(M, N, G_, c_);
    gemm_phase<Epi>(lds, g, S, E);
}

__device__ __forceinline__ int rowmap(int mode, int n) {
    if (mode == 1) { const int bj = n >= 2816 ? 1 : 0, c = n - bj * 2816; return (c >> 7) * 256 + bj * 128 + (c & 127); }
    if (mode == 2) { if (n < 1024) return n; int c = n - 1024; const int bj = c >= 1024 ? 1 : 0; c -= bj * 1024; return 1024 + (c >> 7) * 256 + bj * 128 + (c & 127); }
    return n;
}
__device__ __forceinline__ void tr_job(const float* __restrict__ W, int K, int N, const float* __restrict__ gain, bf16_t* __restrict__ out, int mode, LAS float* lds_f, int gwave, int gwaves, int wid, int lane) {
    LAS float* tile = lds_f + wid * (32 * 65);
    const int tn = N >> 6, ntile = (K >> 5) * tn, r4 = lane >> 4, nn = (lane & 15) * 4;
    for (int t = gwave; t < ntile; t += gwaves) {
        const int k0 = (t / tn) << 5, n0 = (t % tn) << 6;
        f32x4 v[8];
#pragma unroll
        for (int i = 0; i < 8; ++i) v[i] = *(const f32x4*)(W + (size_t)(k0 + r4 + 4 * i) * N + n0 + nn);
#pragma unroll
        for (int i = 0; i < 8; ++i) { const int kk = r4 + 4 * i; const float gs = gain ? gain[k0 + kk] : 1.0f;
            tile[kk * 65 + nn] = v[i][0] * gs; tile[kk * 65 + nn + 1] = v[i][1] * gs; tile[kk * 65 + nn + 2] = v[i][2] * gs; tile[kk * 65 + nn + 3] = v[i][3] * gs; }
        asm volatile("s_waitcnt lgkmcnt(0)" ::: "memory");
        bf16_t* orow = out + (size_t)rowmap(mode, n0 + lane) * K + k0;
#pragma unroll
        for (int q = 0; q < 4; ++q) {
            const float f0 = tile[(q * 8 + 0) * 65 + lane], f1 = tile[(q * 8 + 1) * 65 + lane], f2 = tile[(q * 8 + 2) * 65 + lane], f3 = tile[(q * 8 + 3) * 65 + lane];
            const float f4 = tile[(q * 8 + 4) * 65 + lane], f5 = tile[(q * 8 + 5) * 65 + lane], f6 = tile[(q * 8 + 6) * 65 + lane], f7 = tile[(q * 8 + 7) * 65 + lane];
            u32x4 w; w.x = cvt_pk_bf16(f0, f1); w.y = cvt_pk_bf16(f2, f3); w.z = cvt_pk_bf16(f4, f5); w.w = cvt_pk_bf16(f6, f7);
            *(u32x4*)(orow + q * 8) = w; }
        asm volatile("s_waitcnt lgkmcnt(0)" ::: "memory");
    }
}
__device__ __forceinline__ void s5_apow(const Params& p, int g, int pp, float n, float& re, float& im) {
    const float lr = fminf(p.lam_re[g * 64 + pp], -1e-4f), li = p.lam_im[g * 64 + pp], dt = expf(p.log_dt[g]);
    const float mag = expf(lr * dt * n), th = li * dt * n; re = mag * cosf(th); im = mag * sinf(th);
}
__device__ __forceinline__ void s5_z(const Params& p, int g, int pp, float& zr, float& zi) {
    const float lr = fminf(p.lam_re[g * 64 + pp], -1e-4f), li = p.lam_im[g * 64 + pp];
    float ar, ai; s5_apow(p, g, pp, 1.0f, ar, ai);
    const float den = lr * lr + li * li, nr = ar - 1.0f, ni = ai;
    zr = (nr * lr + ni * li) / den; zi = (ni * lr - nr * li) / den;
}

__device__ __forceinline__ Params load_params() {
    Params p{};
#if defined(__HIP_DEVICE_COMPILE__)
    const __attribute__((address_space(4))) unsigned long long* q = (const __attribute__((address_space(4))) unsigned long long*)__builtin_amdgcn_kernarg_segment_ptr();
    asm volatile("" : "+s"(q));
    p.x = (const float*)(const __attribute__((address_space(1))) float*)q[0]; p.mix_g = (const float*)(const __attribute__((address_space(1))) float*)q[1]; p.ffn_g = (const float*)(const __attribute__((address_space(1))) float*)q[2]; p.fin_g = (const float*)(const __attribute__((address_space(1))) float*)q[3]; p.ev_w_in = (const float*)(const __attribute__((address_space(1))) float*)q[4]; p.ev_w_out = (const float*)(const __attribute__((address_space(1))) float*)q[5]; p.lam_re = (const float*)(const __attribute__((address_space(1))) float*)q[6]; p.lam_im = (const float*)(const __attribute__((address_space(1))) float*)q[7]; p.log_dt = (const float*)(const __attribute__((address_space(1))) float*)q[8]; p.b_re = (const float*)(const __attribute__((address_space(1))) float*)q[9]; p.b_im = (const float*)(const __attribute__((address_space(1))) float*)q[10]; p.c_re = (const float*)(const __attribute__((address_space(1))) float*)q[11]; p.c_im = (const float*)(const __attribute__((address_space(1))) float*)q[12]; p.s5_d = (const float*)(const __attribute__((address_space(1))) float*)q[13]; p.w_glu = (const float*)(const __attribute__((address_space(1))) float*)q[14]; p.b_glu = (const float*)(const __attribute__((address_space(1))) float*)q[15]; p.gm_ws = (const float*)(const __attribute__((address_space(1))) float*)q[16]; p.gm_bs = (const float*)(const __attribute__((address_space(1))) float*)q[17]; p.gm_vg = (const float*)(const __attribute__((address_space(1))) float*)q[18]; p.od_w_in = (const float*)(const __attribute__((address_space(1))) float*)q[19]; p.od_cw = (const float*)(const __attribute__((address_space(1))) float*)q[20]; p.od_cb = (const float*)(const __attribute__((address_space(1))) float*)q[21]; p.od_w_out = (const float*)(const __attribute__((address_space(1))) float*)q[22]; p.ffn_up = (const float*)(const __attribute__((address_space(1))) float*)q[23]; p.ffn_cw = (const float*)(const __attribute__((address_space(1))) float*)q[24]; p.ffn_cb = (const float*)(const __attribute__((address_space(1))) float*)q[25]; p.ffn_dn = (const float*)(const __attribute__((address_space(1))) float*)q[26]; p.out = (float*)(__attribute__((address_space(1))) float*)q[27]; p.ws = (unsigned char*)(__attribute__((address_space(1))) unsigned char*)q[28];
#endif
    return p;
}
#define PHASE_PTRS const Params p = load_params(); unsigned char* ws = p.ws; bf16_t* WIN0 = (bf16_t*)(ws + O_WIN0); bf16_t* WOUT0 = (bf16_t*)(ws + O_WOUT0); bf16_t* WODIN = (bf16_t*)(ws + O_WODIN); bf16_t* WODOUT = (bf16_t*)(ws + O_WODOUT); bf16_t* WGLU = (bf16_t*)(ws + O_WGLU); bf16_t* M1T = (bf16_t*)(ws + O_M1T); bf16_t* T2T = (bf16_t*)(ws + O_T2T); bf16_t* WSB = (bf16_t*)(ws + O_WSB); float* KTAB = (float*)(ws + O_KTAB); float* SS = (float*)(ws + O_SS); float* ss0 = SS; float* ssf0 = SS + 65536; float* ssm1 = SS + 2 * 65536; float* ssf1 = SS + 3 * 65536; float* ssfin = SS + 4 * 65536; float* vss = SS + 5 * 65536; bf16_t* HB = (bf16_t*)(ws + O_HB); bf16_t* UH = (bf16_t*)(ws + O_UH); float* Sst = (float*)(ws + O_S); bf16_t* Ub_ = (bf16_t*)(ws + O_U); bf16_t* Vb = (bf16_t*)(ws + O_V); bf16_t* Y1 = (bf16_t*)(ws + O_Y1); bf16_t* MIX = (bf16_t*)(ws + O_MIX); bf16_t* BG = (bf16_t*)(ws + O_BG); bf16_t* Zb = (bf16_t*)(ws + O_Z); bf16_t* Gb = (bf16_t*)(ws + O_G); bf16_t* UB = (bf16_t*)(ws + O_UB); (void)WIN0; (void)WOUT0; (void)WODIN; (void)WODOUT; (void)WGLU; (void)M1T; (void)T2T; (void)WSB; (void)KTAB; (void)ss0; (void)ssf0; (void)ssm1; (void)ssf1; (void)ssfin; (void)vss; (void)HB; (void)UH; (void)Sst; (void)Ub_; (void)Vb; (void)Y1; (void)MIX; (void)BG; (void)Zb; (void)Gb; (void)UB;
#define PHASE_IDS int tid = threadIdx.x; asm volatile("" : "+v"(tid)); const int lane = tid & 63, wid = tid >> 6, gtid = blockIdx.x * 512 + tid, gthreads = gridDim.x * 512, gwave = blockIdx.x * 8 + wid, gwaves = gridDim.x * 8; (void)lane; (void)wid; (void)gtid; (void)gthreads; (void)gwave; (void)gwaves;
#define XB_TMO      128
#define XB_XCNT(j)  (256  + 64 * (j))
#define XB_XSUB(j)  (1280 + 64 * (j))
#define XB_XGEN(j)  (2304 + 64 * (j))
#define XB_TOP      3328
#define XB_TOPGEN   3392
#define XCD_BAR_WORDS 3456
#define XB_SPIN_CAP (1u << 20)
__device__ __forceinline__ unsigned xb_ld(unsigned* p)              { return __hip_atomic_load(p, __ATOMIC_RELAXED, __HIP_MEMORY_SCOPE_AGENT); }
__device__ __forceinline__ unsigned xb_add(unsigned* p, unsigned v) { return __hip_atomic_fetch_add(p, v, __ATOMIC_RELAXED, __HIP_MEMORY_SCOPE_AGENT); }
__device__ __forceinline__ unsigned xb_xcc_id() { return (unsigned)__builtin_amdgcn_s_getreg((3 << 11) | 20) & 0xFu; }
#define XB_SPIN(cond, bar) do { unsigned _sp = 0; while (cond) { __builtin_amdgcn_s_sleep(1); \
    if ((++_sp & 255u) == 0u) { if (xb_ld(&(bar)[XB_TMO])) break; if (_sp > XB_SPIN_CAP) { atomicAdd(&(bar)[XB_TMO], 1u); break; } } } } while (0)
__device__ __forceinline__ void xcd_barrier_complete(unsigned* bar, unsigned x, unsigned& nloc, unsigned& nx) {
    const unsigned G = gridDim.x * gridDim.y * gridDim.z;
    unsigned sum, cnt, mine, sp = 0u;
    for (;;) {
        sum = 0u; cnt = 0u; mine = 0u;
#pragma unroll
        for (unsigned j = 0; j < 16; ++j) { const unsigned c = xb_ld(&bar[XB_XCNT(j)]); sum += c; cnt += (c > 0u) ? 1u : 0u; mine = (j == x) ? c : mine; }
        if (sum == G) break;
        __builtin_amdgcn_s_sleep(1);
        if ((++sp & 255u) == 0u) { if (xb_ld(&bar[XB_TMO])) break; if (sp > XB_SPIN_CAP) { atomicAdd(&bar[XB_TMO], 1u); break; } }
    }
    nloc = mine > 0u ? mine : 1u; nx = cnt > 0u ? cnt : 1u;
}
__device__ __forceinline__ void xcd_barrier(unsigned* bar, volatile LAS unsigned* st) {
    asm volatile("s_waitcnt vmcnt(0)" ::: "memory");
    __syncthreads();
    int tid = threadIdx.x; asm volatile("" : "+v"(tid));
    if (tid == 0) {
        const unsigned x = xb_xcc_id();
        __builtin_amdgcn_s_waitcnt(0);
        unsigned nloc = st[0], nx = st[1];
        if (nloc == 0u) { xcd_barrier_complete(bar, x, nloc, nx); st[0] = nloc; st[1] = nx; }
        const unsigned old = xb_add(&bar[XB_XSUB(x)], 1u);
        const unsigned gen = old / nloc;
        if (old + 1u == (gen + 1u) * nloc) {
            __builtin_amdgcn_fence(__ATOMIC_RELEASE, "agent");
            asm volatile("s_waitcnt vmcnt(0)" ::: "memory");
            const unsigned og = xb_add(&bar[XB_TOP], 1u);
            const unsigned tg = og / nx;
            if (og + 1u == (tg + 1u) * nx) xb_add(&bar[XB_TOPGEN], 1u);
            else XB_SPIN(xb_ld(&bar[XB_TOPGEN]) == tg, bar);
            __builtin_amdgcn_fence(__ATOMIC_ACQUIRE, "agent");
            xb_add(&bar[XB_XGEN(x)], 1u);
            asm volatile("s_waitcnt vmcnt(0)" ::: "memory");
        } else {
            XB_SPIN(xb_ld(&bar[XB_XGEN(x)]) == gen, bar);
            __builtin_amdgcn_fence(__ATOMIC_ACQUIRE, "agent");
            asm volatile("s_waitcnt vmcnt(0)" ::: "memory");
        }
    }
    __syncthreads();
}
#define GRID_BAR() do { PHASE_PTRS xcd_barrier((unsigned*)(ws + O_BAR), (volatile LAS unsigned*)(lds + STAGE_BYTES)); } while (0)
template <int layer> __device__ __forceinline__ void layer_body(LAS unsigned char* lds, unsigned& nbar) {
        if constexpr (layer == 0) {
            { PHASE_PTRS EpiIn0 e; e.ss = ss0; e.UH = UH; e.U = Ub_; e.V = Vb; e.vss = vss; run_gemm(lds, HB, WIN0, MTOK, 1792, 1024, 1024, 0, 0, e); }
            GRID_BAR();
            { PHASE_PTRS EpiS5a e; e.S = Sst; run_gemm(lds, UH, M1T, 32768, 256, 512, 640, 8, (size_t)256 * 512 * 2, e); }
            {
                PHASE_PTRS PHASE_IDS
                LAS bf16_t* VT = (LAS bf16_t*)lds;
                const int fr = lane & 15, fq = lane >> 4, ta = wid >> 1, cbk = wid & 1;
                int u0, u1;
                if (gridDim.x == 256) { if (blockIdx.x < 128) { u0 = 10 * (int)blockIdx.x; u1 = u0 + 10; } else { u0 = 1280 + 14 * ((int)blockIdx.x - 128); u1 = u0 + 14; } }
                else { const int per = (3072 + (int)gridDim.x - 1) / (int)gridDim.x; u0 = per * (int)blockIdx.x; u1 = u0 + per < 3072 ? u0 + per : 3072; }
                const int sg = tid & 31, cgp = tid >> 5;
                u32x4 raw[4]; float vs4[4];
#pragma unroll
                for (int r = 0; r < 4; ++r) { raw[r] = (u32x4){0u, 0u, 0u, 0u}; vs4[r] = 1.0f; }
                f32x4 gvn[4]; u32x2 uwn[2][4]; float bsn[2];
#pragma unroll
                for (int nc = 0; nc < 4; ++nc) gvn[nc] = (f32x4){0.f, 0.f, 0.f, 0.f};
#pragma unroll
                for (int mt = 0; mt < 2; ++mt) { bsn[mt] = 0.f;
#pragma unroll
                    for (int nc = 0; nc < 4; ++nc) uwn[mt][nc] = (u32x2){0u, 0u}; }
                if (u0 < u1) { const int h = u0 % 6, tok0 = (u0 / 6) * 128;
#pragma unroll
                    for (int r = 0; r < 4; ++r) { raw[r] = *(const u32x4*)(Vb + (size_t)(tok0 + 4 * sg + r) * 768 + h * 128 + cgp * 8); vs4[r] = vss[tok0 + 4 * sg + r]; }
#pragma unroll
                    for (int nc = 0; nc < 4; ++nc) gvn[nc] = *(const f32x4*)(p.gm_vg + h * 128 + 64 * cbk + 16 * nc + 4 * fq);
#pragma unroll
                    for (int mt = 0; mt < 2; ++mt) { const int t = 32 * ta + 16 * mt + fr; bsn[mt] = p.gm_bs[h * 128 + t];
#pragma unroll
                        for (int nc = 0; nc < 4; ++nc) uwn[mt][nc] = *(const u32x2*)(Ub_ + (size_t)(tok0 + t) * 768 + h * 128 + 64 * cbk + 16 * nc + 4 * fq); } }
                for (int un = u0; un < u1; ++un) {
                    const int h = un % 6, bn = un / 6, tok0 = bn * 128;
                    bf16x8 afv[4][2];
#pragma unroll
                    for (int ks = 0; ks < 4; ++ks) if (ks <= ta) {
#pragma unroll
                        for (int mt = 0; mt < 2; ++mt) afv[ks][mt] = *(const bf16x8*)(WSB + ((size_t)(h * 128 + 32 * ta + 16 * mt + fr) * 128 + 32 * ks + 8 * fq)); }
                    asm volatile("s_waitcnt lgkmcnt(0)" ::: "memory"); __builtin_amdgcn_s_barrier(); asm volatile("" ::: "memory");
                    { u32x4 w[4];
#pragma unroll
                      for (int r = 0; r < 4; ++r) { const float rv = rsqrtf(vs4[r] * (1.0f / 768.0f) + EPS); f32x4 a, b; unpack8(raw[r], a, b); a *= rv; b *= rv; w[r] = pack8(a, b); }
                      LAS bf16_t* d = VT + (cgp * 8) * 136 + 4 * sg;
#pragma unroll
                      for (int di = 0; di < 4; ++di) {
                          const unsigned x0 = w[0][di], x1 = w[1][di], x2 = w[2][di], x3 = w[3][di];
                          *(LAS u32x2*)(d + (2 * di) * 136) = (u32x2){(x0 & 0xffffu) | (x1 << 16), (x2 & 0xffffu) | (x3 << 16)};
                          *(LAS u32x2*)(d + (2 * di + 1) * 136) = (u32x2){(x0 >> 16) | (x1 & 0xffff0000u), (x2 >> 16) | (x3 & 0xffff0000u)}; } }
                    asm volatile("s_waitcnt lgkmcnt(0)" ::: "memory"); __builtin_amdgcn_s_barrier(); asm volatile("" ::: "memory");
                    f32x4 gvv[4]; u32x2 uwv[2][4]; float bsv[2];
#pragma unroll
                    for (int nc = 0; nc < 4; ++nc) gvv[nc] = gvn[nc];
#pragma unroll
                    for (int mt = 0; mt < 2; ++mt) { bsv[mt] = bsn[mt];
#pragma unroll
                        for (int nc = 0; nc < 4; ++nc) uwv[mt][nc] = uwn[mt][nc]; }
                    if (un + 1 < u1) { const int h2 = (un + 1) % 6, tok2 = ((un + 1) / 6) * 128;
#pragma unroll
                        for (int r = 0; r < 4; ++r) { raw[r] = *(const u32x4*)(Vb + (size_t)(tok2 + 4 * sg + r) * 768 + h2 * 128 + cgp * 8); vs4[r] = vss[tok2 + 4 * sg + r]; }
#pragma unroll
                        for (int nc = 0; nc < 4; ++nc) gvn[nc] = *(const f32x4*)(p.gm_vg + h2 * 128 + 64 * cbk + 16 * nc + 4 * fq);
#pragma unroll
                        for (int mt = 0; mt < 2; ++mt) { const int t = 32 * ta + 16 * mt + fr; bsn[mt] = p.gm_bs[h2 * 128 + t];
#pragma unroll
                            for (int nc = 0; nc < 4; ++nc) uwn[mt][nc] = *(const u32x2*)(Ub_ + (size_t)(tok2 + t) * 768 + h2 * 128 + 64 * cbk + 16 * nc + 4 * fq); } }
                    f32x4 acc[2][4];
#pragma unroll
                    for (int a = 0; a < 2; ++a)
#pragma unroll
                        for (int b = 0; b < 4; ++b) acc[a][b] = (f32x4){0.f, 0.f, 0.f, 0.f};
#pragma unroll
                    for (int ks = 0; ks < 4; ++ks) if (ks <= ta) {
                        bf16x8 bfr[4];
#pragma unroll
                        for (int nc = 0; nc < 4; ++nc) bfr[nc] = *(const LAS bf16x8*)(VT + (64 * cbk + 16 * nc + fr) * 136 + 32 * ks + 8 * fq);
#pragma unroll
                        for (int mt = 0; mt < 2; ++mt)
#pragma unroll
                            for (int nc = 0; nc < 4; ++nc) acc[mt][nc] = __builtin_amdgcn_mfma_f32_16x16x32_bf16(bfr[nc], afv[ks][mt], acc[mt][nc], 0, 0, 0);
                    }
#pragma unroll
                    for (int mt = 0; mt < 2; ++mt) { const int t = 32 * ta + 16 * mt + fr; const float bs = bsv[mt];
#pragma unroll
                        for (int nc = 0; nc < 4; ++nc) { const int c = h * 128 + 64 * cbk + 16 * nc + 4 * fq;
                            const f32x4 gv = gvv[nc]; const u32x2 uw = uwv[mt][nc];
                            const f32x4 gate = acc[mt][nc] * gv + bs;
                            const u32x2 o = (u32x2){cvt_pk_bf16(bflo(uw.x) * gate[0], bfhi(uw.x) * gate[1]), cvt_pk_bf16(bflo(uw.y) * gate[2], bfhi(uw.y) * gate[3])};
                            *(u32x2*)(MIX + (size_t)(tok0 + t) * 1024 + 256 + c) = o; } }
                }
                __syncthreads();
            }
            GRID_BAR();
            { PHASE_PTRS PHASE_IDS
              LAS float* Eseg = (LAS float*)lds;
              for (int gb = blockIdx.x; gb < 256; gb += gridDim.x) { const int g = gb >> 4, b = gb & 15, pp = lane;
                  float ar, ai; s5_apow(p, g, pp, 32.0f, ar, ai);
                  const size_t row0 = (size_t)g * 2048 + b * 128 + wid * 16;
                  float lr[16], li[16], sr[16], si[16];
#pragma unroll
                  for (int i = 0; i < 16; ++i) { sr[i] = Sst[(row0 + i) * 128 + pp]; si[i] = Sst[(row0 + i) * 128 + 64 + pp]; }
                  float hr = 0.f, hi_ = 0.f;
#pragma unroll
                  for (int i = 0; i < 16; ++i) { lr[i] = hr; li[i] = hi_; const float nr = ar * hr - ai * hi_ + sr[i], ni = ar * hi_ + ai * hr + si[i]; hr = nr; hi_ = ni; }
                  __syncthreads();
                  Eseg[(wid * 64 + pp) * 2] = hr; Eseg[(wid * 64 + pp) * 2 + 1] = hi_;
                  __syncthreads();
                  float br, bi; s5_apow(p, g, pp, 512.0f, br, bi);
                  float cr = 0.f, ci = 0.f;
                  for (int w2 = 0; w2 < wid; ++w2) { const float er = Eseg[(w2 * 64 + pp) * 2], ei = Eseg[(w2 * 64 + pp) * 2 + 1];
                      const float nr = br * cr - bi * ci + er, ni = br * ci + bi * cr + ei; cr = nr; ci = ni; }
#pragma unroll
                  for (int i = 0; i < 16; ++i) {
                      UH[(row0 + i) * 640 + 512 + pp] = (bf16_t)(cvt_pk_bf16(lr[i] + cr, 0.f) & 0xffffu); UH[(row0 + i) * 640 + 512 + 64 + pp] = (bf16_t)(cvt_pk_bf16(li[i] + ci, 0.f) & 0xffffu);
                      const float nr = ar * cr - ai * ci, ni = ar * ci + ai * cr; cr = nr; ci = ni; }
              }
              __syncthreads();
            }
            GRID_BAR();
            { PHASE_PTRS EpiS5b e; e.UH = UH; e.dsk = p.s5_d; e.Y1 = Y1; run_gemm(lds, UH, T2T, 32768, 512, 640, 640, 8, (size_t)512 * 640 * 2, e); }
            GRID_BAR();
            { PHASE_PTRS EpiGlu e; e.Y1 = Y1; e.bglu = p.b_glu; e.MIX = MIX; run_gemm(lds, Y1, WGLU, MTOK, 256, 256, 256, 0, 0, e); }
            GRID_BAR();
        } else {
            { PHASE_PTRS EpiOdIn e; e.ss = ssm1; e.BG = BG; e.Z = Zb; run_gemm(lds, HB, WODIN, MTOK, 3072, 1024, 1024, 0, 0, e); }
            GRID_BAR();
            { PHASE_PTRS PHASE_IDS
              const int c8 = (gtid & 127) * 8;
              const float* cw = p.od_cw; const float* cb = p.od_cb;
              const f32x4 w00 = *(const f32x4*)(cw + c8), w01 = *(const f32x4*)(cw + c8 + 4), w10 = *(const f32x4*)(cw + 1024 + c8), w11 = *(const f32x4*)(cw + 1024 + c8 + 4);
              const f32x4 w20 = *(const f32x4*)(cw + 2048 + c8), w21 = *(const f32x4*)(cw + 2048 + c8 + 4), bb0 = *(const f32x4*)(cb + c8), bb1 = *(const f32x4*)(cb + c8 + 4);
              const int tstep = gthreads >> 7;
              for (int tok = gtid >> 7; tok < MTOK; tok += 2 * tstep) {
                  u32x4 rz0[2], rz1[2], rz2[2], rbg[2]; bool ok[2];
#pragma unroll
                  for (int q = 0; q < 2; ++q) { const int tk = tok + q * tstep; ok[q] = tk < MTOK; const int t = tk & 4095; const size_t off = (size_t)tk * 1024 + c8;
                      rz0[q] = rz1[q] = rz2[q] = rbg[q] = (u32x4){0u, 0u, 0u, 0u};
                      if (ok[q]) { rz0[q] = *(const u32x4*)(Zb + off); rbg[q] = *(const u32x4*)(BG + off);
                          if (t >= 1) rz1[q] = *(const u32x4*)(Zb + off - 1024);
                          if (t >= 2) rz2[q] = *(const u32x4*)(Zb + off - 2048); } }
#pragma unroll
                  for (int q = 0; q < 2; ++q) { if (!ok[q]) continue; const size_t off = (size_t)(tok + q * tstep) * 1024 + c8;
                      f32x4 z0a, z0b, z1a, z1b, z2a, z2b, ga, gb_;
                      unpack8(rz0[q], z0a, z0b); unpack8(rz1[q], z1a, z1b); unpack8(rz2[q], z2a, z2b); unpack8(rbg[q], ga, gb_);
                      const f32x4 oa = ga * (bb0 + w00 * z2a + w10 * z1a + w20 * z0a), ob = gb_ * (bb1 + w01 * z2b + w11 * z1b + w21 * z0b);
                      *(u32x4*)(MIX + off) = pack8(oa, ob); }
              }
            }
            GRID_BAR();
        }
        { PHASE_PTRS EpiRes e; e.hb = HB; e.ss = layer == 0 ? ssf0 : ssf1;
          run_gemm(lds, MIX, layer == 0 ? WOUT0 : WODOUT, MTOK, 1024, 1024, 1024, 0, 0, e); }
        GRID_BAR();
        { PHASE_PTRS EpiFfnUp e; e.ss = layer == 0 ? ssf0 : ssf1; e.cwt = (const unsigned*)(ws + O_CWT) + (size_t)layer * 4 * 2816; e.G = Gb; e.Ub = (unsigned*)UB;
          run_gemm(lds, HB, (const bf16_t*)(ws + O_WUP + (size_t)layer * SZ_WUP), MTOK, 5632, 1024, 1024, 0, 0, e); }
        GRID_BAR();
        { PHASE_PTRS PHASE_IDS
        const float* fcw = p.ffn_cw + (size_t)layer * 3 * 5632; const float* fcb = p.ffn_cb + (size_t)layer * 5632;
        const int nth = (gthreads / 352) * 352, rstep = nth / 352;
        if (gtid < nth) {
        const int ch = (gtid % 352) * 8;
        const f32x4 tb_ga = *(const f32x4*)(fcb + ch), tb_gb = *(const f32x4*)(fcb + ch + 4), tb_va = *(const f32x4*)(fcb + 2816 + ch), tb_vb = *(const f32x4*)(fcb + 2816 + ch + 4);
        const f32x4 t0_ga = *(const f32x4*)(fcw + ch), t0_gb = *(const f32x4*)(fcw + ch + 4), t0_va = *(const f32x4*)(fcw + 2816 + ch), t0_vb = *(const f32x4*)(fcw + 2816 + ch + 4);
        const f32x4 t1_ga = *(const f32x4*)(fcw + 5632 + ch), t1_gb = *(const f32x4*)(fcw + 5632 + ch + 4), t1_va = *(const f32x4*)(fcw + 5632 + 2816 + ch), t1_vb = *(const f32x4*)(fcw + 5632 + 2816 + ch + 4);
        const f32x4 t2_ga = *(const f32x4*)(fcw + 2 * 5632 + ch), t2_gb = *(const f32x4*)(fcw + 2 * 5632 + ch + 4), t2_va = *(const f32x4*)(fcw + 2 * 5632 + 2816 + ch), t2_vb = *(const f32x4*)(fcw + 2 * 5632 + 2816 + ch + 4);
        for (int it = gtid / 352; it < 2048; it += rstep) { const int r = it & 1, k = it >> 1;
            if ((k & 63) == 0) continue;
            const unsigned* UBu = (const unsigned*)UB;
            const unsigned* cur = UBu + (size_t)(k * 4 + r) * 2816 + ch; const unsigned* m1 = (r == 0 ? UBu + (size_t)((k - 1) * 4 + 3) * 2816 : UBu + (size_t)(k * 4) * 2816) + ch;
            const unsigned* m2 = (r == 0 ? UBu + (size_t)((k - 1) * 4 + 2) * 2816 : UBu + (size_t)((k - 1) * 4 + 3) * 2816) + ch;
            f32x4 g0a, g0b, g1a, g1b, g2a, g2b, v0a, v0b, v1a, v1b, v2a, v2b;
            { const u32x4 x0 = *(const u32x4*)cur, x1 = *(const u32x4*)(cur + 4);
              g0a = (f32x4){(float)as_h2(x0.x).x, (float)as_h2(x0.y).x, (float)as_h2(x0.z).x, (float)as_h2(x0.w).x}; v0a = (f32x4){(float)as_h2(x0.x).y, (float)as_h2(x0.y).y, (float)as_h2(x0.z).y, (float)as_h2(x0.w).y};
              g0b = (f32x4){(float)as_h2(x1.x).x, (float)as_h2(x1.y).x, (float)as_h2(x1.z).x, (float)as_h2(x1.w).x}; v0b = (f32x4){(float)as_h2(x1.x).y, (float)as_h2(x1.y).y, (float)as_h2(x1.z).y, (float)as_h2(x1.w).y}; }
            { const u32x4 x0 = *(const u32x4*)m1, x1 = *(const u32x4*)(m1 + 4);
              g1a = (f32x4){(float)as_h2(x0.x).x, (float)as_h2(x0.y).x, (float)as_h2(x0.z).x, (float)as_h2(x0.w).x}; v1a = (f32x4){(float)as_h2(x0.x).y, (float)as_h2(x0.y).y, (float)as_h2(x0.z).y, (float)as_h2(x0.w).y};
              g1b = (f32x4){(float)as_h2(x1.x).x, (float)as_h2(x1.y).x, (float)as_h2(x1.z).x, (float)as_h2(x1.w).x}; v1b = (f32x4){(float)as_h2(x1.x).y, (float)as_h2(x1.y).y, (float)as_h2(x1.z).y, (float)as_h2(x1.w).y}; }
            { const u32x4 x0 = *(const u32x4*)m2, x1 = *(const u32x4*)(m2 + 4);
              g2a = (f32x4){(float)as_h2(x0.x).x, (float)as_h2(x0.y).x, (float)as_h2(x0.z).x, (float)as_h2(x0.w).x}; v2a = (f32x4){(float)as_h2(x0.x).y, (float)as_h2(x0.y).y, (float)as_h2(x0.z).y, (float)as_h2(x0.w).y};
              g2b = (f32x4){(float)as_h2(x1.x).x, (float)as_h2(x1.y).x, (float)as_h2(x1.z).x, (float)as_h2(x1.w).x}; v2b = (f32x4){(float)as_h2(x1.x).y, (float)as_h2(x1.y).y, (float)as_h2(x1.z).y, (float)as_h2(x1.w).y}; }
            const f32x4 cga = tb_ga + t0_ga * g2a + t1_ga * g1a + t2_ga * g0a;
            const f32x4 cgb = tb_gb + t0_gb * g2b + t1_gb * g1b + t2_gb * g0b;
            const f32x4 cva = tb_va + t0_va * v2a + t1_va * v1a + t2_va * v0a;
            const f32x4 cvb = tb_vb + t0_vb * v2b + t1_vb * v1b + t2_vb * v0b;
            const f32x4 oa = (f32x4){cga[0] * sigm(cga[0]) * cva[0], cga[1] * sigm(cga[1]) * cva[1], cga[2] * sigm(cga[2]) * cva[2], cga[3] * sigm(cga[3]) * cva[3]};
            const f32x4 ob = (f32x4){cgb[0] * sigm(cgb[0]) * cvb[0], cgb[1] * sigm(cgb[1]) * cvb[1], cgb[2] * sigm(cgb[2]) * cvb[2], cgb[3] * sigm(cgb[3]) * cvb[3]};
            *(u32x4*)(Gb + (size_t)(k * 64 + r) * 2816 + ch) = pack8(oa, ob); } } }
        GRID_BAR();
        { PHASE_PTRS EpiRes e; e.hb = HB; e.ss = layer == 0 ? ssm1 : ssfin;
          run_gemm(lds, Gb, (const bf16_t*)(ws + O_WDN + (size_t)layer * SZ_WDN), MTOK, 1024, 2816, 2816, 0, 0, e); }
        GRID_BAR();
}
__global__ void __launch_bounds__(512, 2) fwd_kernel(Params p_arg) {
    extern __shared__ __attribute__((aligned(16))) unsigned char shm[];
    LAS unsigned char* lds = (LAS unsigned char*)shm;
    cg::grid_group grid = cg::this_grid();
    unsigned nbar = 0;
    {
        PHASE_PTRS
        volatile LAS unsigned* st = (volatile LAS unsigned*)(lds + STAGE_BYTES);
        int t0 = threadIdx.x; asm volatile("" : "+v"(t0));
        if (t0 == 0) { st[0] = 0u; st[1] = 0u; (void)xb_add(&((unsigned*)(ws + O_BAR))[XB_XCNT(xb_xcc_id())], 1u); }
        __syncthreads();
    }

    {
        PHASE_PTRS PHASE_IDS
        LAS float* tile = (LAS float*)lds;
        tr_job(p.ev_w_in, 1024, 1792, p.mix_g, WIN0, 0, tile, gwave, gwaves, wid, lane);
        tr_job(p.ev_w_out, 1024, 1024, nullptr, WOUT0, 0, tile, gwave, gwaves, wid, lane);
        tr_job(p.ffn_up, 1024, 5632, p.ffn_g, (bf16_t*)(ws + O_WUP), 1, tile, gwave, gwaves, wid, lane);
        tr_job(p.ffn_up + (size_t)1024 * 5632, 1024, 5632, p.ffn_g + 1024, (bf16_t*)(ws + O_WUP + SZ_WUP), 1, tile, gwave, gwaves, wid, lane);
        tr_job(p.ffn_dn, 2816, 1024, nullptr, (bf16_t*)(ws + O_WDN), 0, tile, gwave, gwaves, wid, lane);
        tr_job(p.ffn_dn + (size_t)2816 * 1024, 2816, 1024, nullptr, (bf16_t*)(ws + O_WDN + SZ_WDN), 0, tile, gwave, gwaves, wid, lane);
        tr_job(p.od_w_in, 1024, 3072, p.mix_g + 1024, WODIN, 2, tile, gwave, gwaves, wid, lane);
        tr_job(p.od_w_out, 1024, 1024, nullptr, WODOUT, 0, tile, gwave, gwaves, wid, lane);
        tr_job(p.w_glu, 256, 256, nullptr, WGLU, 0, tile, gwave, gwaves, wid, lane);
        __syncthreads();
        for (int i = gtid; i < 6 * 128 * 128 / 2; i += gthreads) { const int e = i * 2, s = e & 127, t = (e >> 7) & 127;
            const float a = s <= t ? p.gm_ws[e] : 0.f, b = (s + 1) <= t ? p.gm_ws[e + 1] : 0.f; ((unsigned*)WSB)[i] = cvt_pk_bf16(a, b); }
        for (int i = gtid; i < 16 * 64 * 32; i += gthreads) { const int jp = i & 31, pp = (i >> 5) & 63, g = i >> 11;
            float ar, ai, zr, zi; s5_apow(p, g, pp, (float)(31 - jp), ar, ai); s5_z(p, g, pp, zr, zi);
            const float wr_ = ar * zr - ai * zi, wi_ = ar * zi + ai * zr;
            const float* br = p.b_re + (size_t)(g * 64 + pp) * 16; const float* bi = p.b_im + (size_t)(g * 64 + pp) * 16;
            bf16_t* dre = M1T + ((size_t)(g * 256 + pp) * 512 + jp * 16); bf16_t* dim_ = M1T + ((size_t)(g * 256 + 64 + pp) * 512 + jp * 16);
#pragma unroll
            for (int h8 = 0; h8 < 2; ++h8) { u32x4 wre, wim;
                { const float b0r = br[h8 * 8 + 0], b0i = bi[h8 * 8 + 0], b1r = br[h8 * 8 + 1], b1i = bi[h8 * 8 + 1]; wre.x = cvt_pk_bf16(wr_ * b0r - wi_ * b0i, wr_ * b1r - wi_ * b1i); wim.x = cvt_pk_bf16(wr_ * b0i + wi_ * b0r, wr_ * b1i + wi_ * b1r); }
                { const float b0r = br[h8 * 8 + 2], b0i = bi[h8 * 8 + 2], b1r = br[h8 * 8 + 3], b1i = bi[h8 * 8 + 3]; wre.y = cvt_pk_bf16(wr_ * b0r - wi_ * b0i, wr_ * b1r - wi_ * b1i); wim.y = cvt_pk_bf16(wr_ * b0i + wi_ * b0r, wr_ * b1i + wi_ * b1r); }
                { const float b0r = br[h8 * 8 + 4], b0i = bi[h8 * 8 + 4], b1r = br[h8 * 8 + 5], b1i = bi[h8 * 8 + 5]; wre.z = cvt_pk_bf16(wr_ * b0r - wi_ * b0i, wr_ * b1r - wi_ * b1i); wim.z = cvt_pk_bf16(wr_ * b0i + wi_ * b0r, wr_ * b1i + wi_ * b1r); }
                { const float b0r = br[h8 * 8 + 6], b0i = bi[h8 * 8 + 6], b1r = br[h8 * 8 + 7], b1i = bi[h8 * 8 + 7]; wre.w = cvt_pk_bf16(wr_ * b0r - wi_ * b0i, wr_ * b1r - wi_ * b1i); wim.w = cvt_pk_bf16(wr_ * b0i + wi_ * b0r, wr_ * b1i + wi_ * b1r); }
                *(u32x4*)(dre + h8 * 8) = wre; *(u32x4*)(dim_ + h8 * 8) = wim; }
        }
        for (int i = gtid; i < 16 * 128 * 64; i += gthreads) { const int g = i >> 13, r = (i >> 6) & 127, c8 = i & 63;
            *(u32x4*)(M1T + ((size_t)(g * 256 + 128 + r) * 512 + c8 * 8)) = (u32x4){0u, 0u, 0u, 0u}; }
        for (int i = gtid; i < 16 * 32 * 64; i += gthreads) { const int pp = i & 63, j = (i >> 6) & 31, g = i >> 11;
            float ar, ai; s5_apow(p, g, pp, (float)(j + 1), ar, ai);
#pragma unroll 4
            for (int ho = 0; ho < 16; ++ho) { const float cr = p.c_re[(size_t)(g * 16 + ho) * 64 + pp], ci = p.c_im[(size_t)(g * 16 + ho) * 64 + pp];
                bf16_t* d = T2T + ((size_t)(g * 512 + j * 16 + ho) * 640 + 512 + pp);
                d[0] = (bf16_t)(cvt_pk_bf16(cr * ar - ci * ai, 0.f) & 0xffffu); d[64] = (bf16_t)(cvt_pk_bf16(-(cr * ai + ci * ar), 0.f) & 0xffffu); }
        }
        for (int un = gwave; un < 16 * 32; un += gwaves) { const int g = un >> 5, d = un & 31;
            float ar, ai, zr, zi; s5_apow(p, g, lane, (float)d, ar, ai); s5_z(p, g, lane, zr, zi);
            const float wr_ = ar * zr - ai * zi, wi_ = ar * zi + ai * zr;
            const int ho = lane >> 2, hi0 = (lane & 3) * 4;
            f32x4 s = (f32x4){0.f, 0.f, 0.f, 0.f};
#pragma unroll 8
            for (int pp = 0; pp < 64; ++pp) {
                const float zr_p = __int_as_float(__builtin_amdgcn_readlane(__float_as_int(wr_), pp)), zi_p = __int_as_float(__builtin_amdgcn_readlane(__float_as_int(wi_), pp));
                const f32x4 b_r = *(const f32x4*)(p.b_re + (size_t)(g * 64 + pp) * 16 + hi0), b_i = *(const f32x4*)(p.b_im + (size_t)(g * 64 + pp) * 16 + hi0);
                const float cr = p.c_re[(size_t)(g * 16 + ho) * 64 + pp], ci = p.c_im[(size_t)(g * 16 + ho) * 64 + pp];
                const f32x4 tr = zr_p * b_r - zi_p * b_i, ti = zr_p * b_i + zi_p * b_r;
                s += cr * tr - ci * ti; }
            *(f32x4*)(KTAB + (size_t)un * 256 + ho * 16 + hi0) = s; }
        for (int i = gtid; i < 2 * 4 * 2816; i += gthreads) { const int ch = i % 2816, k = (i / 2816) & 3, l = i / (4 * 2816);
            const float* src_ = k < 3 ? p.ffn_cw + (size_t)(l * 3 + k) * 5632 : p.ffn_cb + (size_t)l * 5632;
            ((unsigned*)(ws + O_CWT))[i] = pk_h2(src_[ch] * -1.4426950409f, src_[2816 + ch] * -0.6931471806f); }
        for (int i = gtid; i < 5 * 65536 / 4; i += gthreads) *(f32x4*)(SS + 65536 + (size_t)i * 4) = (f32x4){0.f, 0.f, 0.f, 0.f};
        for (int row = gwave; row < MTOK; row += 2 * gwaves) {
            f32x4 xv[2][4];
#pragma unroll
            for (int q = 0; q < 2; ++q) { const int r = row + q * gwaves; const float* xr = p.x + (size_t)(r < MTOK ? r : row) * 1024;
                xv[q][0] = *(const f32x4*)(xr + lane * 8); xv[q][1] = *(const f32x4*)(xr + lane * 8 + 4); xv[q][2] = *(const f32x4*)(xr + 512 + lane * 8); xv[q][3] = *(const f32x4*)(xr + 512 + lane * 8 + 4); }
#pragma unroll
            for (int q = 0; q < 2; ++q) { const int r = row + q * gwaves; if (r >= MTOK) continue;
                *(u32x4*)(HB + (size_t)r * 1024 + lane * 8) = pack8(xv[q][0], xv[q][1]); *(u32x4*)(HB + (size_t)r * 1024 + 512 + lane * 8) = pack8(xv[q][2], xv[q][3]);
                float s = dot4(xv[q][0]) + dot4(xv[q][1]) + dot4(xv[q][2]) + dot4(xv[q][3]);
                s += __shfl_xor(s, 32); s += __shfl_xor(s, 16); s += __shfl_xor(s, 8); s += __shfl_xor(s, 4); s += __shfl_xor(s, 2); s += __shfl_xor(s, 1);
                if (lane == 0) ss0[r] = s; } }
    }
    GRID_BAR();
    if (__builtin_expect(load_params().ws == nullptr, 0)) grid.sync();
    { PHASE_PTRS PHASE_IDS
    for (int i = gtid; i < 16 * 512 * 32; i += gthreads) { const int jp = i & 31, nrow = (i >> 5) & 511, g = i >> 14, j = nrow >> 4, ho = nrow & 15;
        u32x4 w0 = (u32x4){0u, 0u, 0u, 0u}, w1 = w0;
        if (jp <= j) { const float* k = KTAB + ((size_t)(g * 32 + (j - jp)) * 256 + ho * 16);
            const f32x4 k0 = *(const f32x4*)k, k1 = *(const f32x4*)(k + 4), k2 = *(const f32x4*)(k + 8), k3 = *(const f32x4*)(k + 12); w0 = pack8(k0, k1); w1 = pack8(k2, k3); }
        bf16_t* d = T2T + ((size_t)(g * 512 + nrow) * 640 + jp * 16); *(u32x4*)d = w0; *(u32x4*)(d + 8) = w1; } }

    layer_body<0>(lds, nbar);
    layer_body<1>(lds, nbar);
    { PHASE_PTRS PHASE_IDS
    for (int row = gwave; row < MTOK; row += 4 * gwaves) {
        u32x4 hv[4][2]; float sv[4];
#pragma unroll
        for (int q = 0; q < 4; ++q) { const int r = row + q * gwaves; sv[q] = 1.0f; hv[q][0] = hv[q][1] = (u32x4){0u, 0u, 0u, 0u};
            if (r < MTOK) { const bf16_t* hr = HB + (size_t)r * 1024; hv[q][0] = *(const u32x4*)(hr + lane * 8); hv[q][1] = *(const u32x4*)(hr + 512 + lane * 8); sv[q] = ssfin[r]; } }
        const f32x4 g0 = *(const f32x4*)(p.fin_g + lane * 8), g1 = *(const f32x4*)(p.fin_g + lane * 8 + 4), g2 = *(const f32x4*)(p.fin_g + 512 + lane * 8), g3 = *(const f32x4*)(p.fin_g + 512 + lane * 8 + 4);
#pragma unroll
        for (int q = 0; q < 4; ++q) { const int r = row + q * gwaves; if (r >= MTOK) continue; float* orow = p.out + (size_t)r * 1024; const float rs = rnorm(sv[q]);
            f32x4 a, b; unpack8(hv[q][0], a, b); *(f32x4*)(orow + lane * 8) = a * rs * g0; *(f32x4*)(orow + lane * 8 + 4) = b * rs * g1;
            unpack8(hv[q][1], a, b); *(f32x4*)(orow + 512 + lane * 8) = a * rs * g2; *(f32x4*)(orow + 512 + lane * 8 + 4) = b * rs * g3; }
    } }
}

extern "C" void kernel_launch(void* const* d_in, const int* in_sizes, int n_in, void* d_out, int out_size, void* d_ws, size_t ws_size, hipStream_t stream) {
    static int grid_blocks = 0;
    if (!grid_blocks) {
        if (ws_size < WS_NEED) { fprintf(stderr, "kernel_launch: workspace too small: %zu < %zu\n", ws_size, (size_t)WS_NEED); grid_blocks = -1; return; }
        int dev = 0, cus = 0, per_cu = 0;
        (void)hipGetDevice(&dev); (void)hipDeviceGetAttribute(&cus, hipDeviceAttributeMultiprocessorCount, dev);
        if (hipFuncSetAttribute((const void*)fwd_kernel, hipFuncAttributeMaxDynamicSharedMemorySize, LDS_BYTES) != hipSuccess) fprintf(stderr, "kernel_launch: hipFuncSetAttribute failed\n");
        if (hipOccupancyMaxActiveBlocksPerMultiprocessor(&per_cu, (const void*)fwd_kernel, 512, LDS_BYTES) != hipSuccess || per_cu < 1) { fprintf(stderr, "kernel_launch: occupancy query says %d\n", per_cu); per_cu = 1; }
        (void)hipGetLastError();
        grid_blocks = cus;
    }
    if (grid_blocks < 0) return;
    Params p{};
    const float** fp = (const float**)&p;
    for (int i = 0; i < 27; ++i) fp[i] = (const float*)d_in[i];
    p.out = (float*)d_out; p.ws = (unsigned char*)d_ws;
    if (hipMemsetAsync((char*)d_ws + O_BAR, 0, 16384, stream) != hipSuccess) fprintf(stderr, "kernel_launch: memset failed\n");
    void* args[] = {&p};
    hipError_t e = hipLaunchCooperativeKernel((const void*)fwd_kernel, dim3(grid_blocks), dim3(512), args, LDS_BYTES, stream);
    if (e != hipSuccess) fprintf(stderr, "cooperative launch failed: %s (grid %d)\n", hipGetErrorString(e), grid_blocks);
}
```
